# Optimizing an MI355X kernel written in HIP

```python
import math
import jax, jax.numpy as jnp
from jax import lax
import numpy as np

D_MODEL = 2048
BATCH = 2
SEQ = 4096
DEPTH = 2

N_MIXERS = 2
BLOCK = 128
HEAD_DIM = 128
DIL_GROUPS = ((128, 1), (512, 4), (2048, 16))
N_GROUPS = len(DIL_GROUPS)
A_HEADS_PER_GROUP = D_MODEL // HEAD_DIM
A_HEADS = N_GROUPS * A_HEADS_PER_GROUP
A_PROJ = N_GROUPS * 3 * A_HEADS_PER_GROUP * HEAD_DIM
B_HEADS = D_MODEL // HEAD_DIM
B_PROJ = 3 * B_HEADS * HEAD_DIM
MIX_WIDTH = D_MODEL
REL_BUCKETS = 32
REL_MAX_DIST = 2048
PEER_HEADS = 8
N_SUBKEYS = 128
N_EXPERTS = N_SUBKEYS * N_SUBKEYS
PEER_QDIM = 256
PEER_TOPK = 16
PEER_CHUNK = 128
N_A_LAYERS = (DEPTH + 1) // 2
N_B_LAYERS = DEPTH // 2
EPS = 1e-6

kernel_name = "hybrid_dilated_stickbreak_peer_adaln"


def rms_norm(x, g):
    xf = x.astype(jnp.float32)
    y = xf * lax.rsqrt(jnp.mean(xf * xf, axis=-1, keepdims=True) + EPS)
    return (y * g).astype(x.dtype)


def modulate(xn, shift, scale):
    return xn * (1 + scale[:, None, :]) + shift[:, None, :]


def rel_bucket(dist):
    exact = REL_BUCKETS // 2
    d_f = jnp.maximum(dist, exact).astype(jnp.float32)
    log_b = exact + (jnp.log(d_f / exact) / math.log(REL_MAX_DIST / exact)
                     * (REL_BUCKETS - exact)).astype(jnp.int32)
    return jnp.where(dist < exact, dist, jnp.minimum(log_b, REL_BUCKETS - 1))


def dilated_band(q, k, v, table_g, window, dil):
    b_, s_, h_, e_ = q.shape
    w_steps = window // dil
    sub_len = s_ // dil
    nb = -(-sub_len // BLOCK)
    lp = nb * BLOCK

    def to_sub(t):
        return t.reshape(b_, sub_len, dil, h_, e_).transpose(0, 2, 1, 3, 4)

    qs = jnp.pad(to_sub(q), ((0, 0), (0, 0), (0, lp - sub_len), (0, 0), (0, 0)))
    qs = qs.reshape(b_, dil, nb, BLOCK, h_, e_)

    def band(t):
        tp = jnp.pad(to_sub(t), ((0, 0), (0, 0), (BLOCK, lp - sub_len), (0, 0), (0, 0)))
        tp = tp.reshape(b_, dil, nb + 1, BLOCK, h_, e_)
        return jnp.concatenate([tp[:, :, :-1], tp[:, :, 1:]], axis=3)

    ks, vs = band(k), band(v)
    qi = jnp.arange(BLOCK)[:, None]
    ci = jnp.arange(2 * BLOCK)[None, :]
    delta = qi + BLOCK - ci
    in_band = (delta >= 0) & (delta <= w_steps)
    key_pos = jnp.arange(nb)[:, None] * BLOCK + ci - BLOCK
    mask = in_band[None] & (key_pos >= 0)[:, None, :]
    bucket = rel_bucket(jnp.clip(delta, 0, w_steps) * dil)
    bias = jnp.moveaxis(table_g[bucket], -1, 0).astype(jnp.float32)

    logits = jnp.einsum('bdnqhe,bdnkhe->bdnhqk', qs, ks).astype(jnp.float32) / math.sqrt(e_)
    logits = jnp.where(mask[:, None], logits + bias, -jnp.inf)
    lse = jax.nn.logsumexp(logits, axis=-1)
    p = jnp.exp(logits - lse[..., None])
    o = jnp.einsum('bdnhqk,bdnkhe->bdnqhe', p.astype(v.dtype), vs)
    o = o.reshape(b_, dil, lp, h_, e_)[:, :, :sub_len].transpose(0, 2, 1, 3, 4).reshape(b_, s_, h_, e_)
    lse = lse.transpose(0, 1, 2, 4, 3).reshape(b_, dil, lp, h_)[:, :, :sub_len]
    lse = lse.transpose(0, 2, 1, 3).reshape(b_, s_, h_)
    return o, lse


def dilated_attention(xm, w_in, q_gain, k_gain, rel_bias):
    b_, s_, _ = xm.shape
    proj = (xm @ w_in).reshape(b_, s_, N_GROUPS, 3, A_HEADS_PER_GROUP, HEAD_DIM)
    outs, lses = [], []
    for g, (window, dil) in enumerate(DIL_GROUPS):
        q = rms_norm(proj[:, :, g, 0], q_gain[g])
        k = rms_norm(proj[:, :, g, 1], k_gain[g])
        v = proj[:, :, g, 2]
        table_g = rel_bias[:, g * A_HEADS_PER_GROUP:(g + 1) * A_HEADS_PER_GROUP]
        o, lse = dilated_band(q, k, v, table_g, window, dil)
        outs.append(o)
        lses.append(lse)
    alpha = jax.nn.softmax(jnp.stack(lses), axis=0)
    out = jnp.einsum('gbsh,gbshe->bshe', alpha, jnp.stack(outs).astype(jnp.float32))
    return out.astype(xm.dtype).reshape(b_, s_, MIX_WIDTH)


def stick_breaking(xm, w_in):
    b_, s_, _ = xm.shape
    proj = (xm @ w_in).reshape(b_, s_, 3, B_HEADS, HEAD_DIM)
    q, k, v = proj[:, :, 0], proj[:, :, 1], proj[:, :, 2]
    scale = 1.0 / math.sqrt(HEAD_DIM)
    outs = []
    for blk in range(s_ // BLOCK):
        t0, t1 = blk * BLOCK, (blk + 1) * BLOCK
        z = jnp.einsum('bqhe,bkhe->bhqk', q[:, t0:t1], k[:, :t1]).astype(jnp.float32) * scale
        before = jnp.arange(t1)[None, :] < (t0 + jnp.arange(BLOCK))[:, None]
        sp = jnp.where(before, jax.nn.softplus(z), 0.0)
        tail = lax.cumsum(sp, axis=3, reverse=True) - sp
        a = jnp.where(before, jnp.exp(jax.nn.log_sigmoid(z) - tail), 0.0)
        outs.append(jnp.einsum('bhqk,bkhe->bqhe', a.astype(v.dtype), v[:, :t1]))
    return jnp.concatenate(outs, axis=1).reshape(b_, s_, MIX_WIDTH)


def peer(xn, w_query, sub_keys, expert_u, expert_v):
    b_, s_, d_ = xn.shape
    half = PEER_QDIM // 2

    def chunk(xc):
        c_ = xc.shape[0]
        q = (xc @ w_query).reshape(c_, PEER_HEADS, 2, half)
        s = jnp.einsum('chpe,hpne->chpn', q, sub_keys)
        sv, si = lax.top_k(s, PEER_TOPK)
        cand = (sv[:, :, 0, :, None] + sv[:, :, 1, None, :]).reshape(c_, PEER_HEADS, PEER_TOPK * PEER_TOPK)
        best, bi = lax.top_k(cand, PEER_TOPK)
        i1 = jnp.take_along_axis(si[:, :, 0], bi // PEER_TOPK, axis=-1)
        i2 = jnp.take_along_axis(si[:, :, 1], bi % PEER_TOPK, axis=-1)
        e = i1 * N_SUBKEYS + i2
        gate = jax.nn.softmax(best.astype(jnp.float32), axis=-1)
        hid = jax.nn.gelu(jnp.einsum('chkd,cd->chk', expert_u[e], xc).astype(jnp.float32), approximate=False)
        return jnp.einsum('chk,chkd->cd', (hid * gate).astype(xc.dtype), expert_v[e])

    out = lax.map(chunk, xn.reshape(-1, PEER_CHUNK, d_))
    return out.reshape(b_, s_, d_)


def setup_inputs(seed: int = 0) -> dict:
    key = jax.random.key(seed)
    ks = jax.random.split(key, 20)
    f32 = jnp.float32
    nrm = lambda k, shape, s: jax.random.normal(k, shape, f32) * s
    D = D_MODEL
    return {
        "x": nrm(ks[0], (BATCH, SEQ, D), 1.0),
        "c": nrm(ks[1], (BATCH, D), 1.0),
        "rel_bias": nrm(ks[2], (REL_BUCKETS, A_HEADS), 0.5),
        "norm1_g": 1.0 + nrm(ks[3], (DEPTH, D), 0.02),
        "norm2_g": 1.0 + nrm(ks[4], (DEPTH, D), 0.02),
        "w_ada": nrm(ks[5], (DEPTH, D, 6 * D), 0.5 * D ** -0.5),
        "b_ada": nrm(ks[6], (DEPTH, 6 * D), 0.01),
        "a_w_in": nrm(ks[7], (N_A_LAYERS, D, A_PROJ), D ** -0.5),
        "a_q_gain": 1.0 + nrm(ks[8], (N_A_LAYERS, N_GROUPS, HEAD_DIM), 0.02),
        "a_k_gain": 1.0 + nrm(ks[9], (N_A_LAYERS, N_GROUPS, HEAD_DIM), 0.02),
        "b_w_in": nrm(ks[10], (N_B_LAYERS, D, B_PROJ), D ** -0.5),
        "w_out": nrm(ks[11], (DEPTH, MIX_WIDTH, D), MIX_WIDTH ** -0.5),
        "peer_w_query": nrm(ks[12], (DEPTH, D, PEER_HEADS * PEER_QDIM), D ** -0.5),
        "peer_sub_keys": nrm(ks[13], (DEPTH, PEER_HEADS, 2, N_SUBKEYS, PEER_QDIM // 2), (PEER_QDIM // 2) ** -0.5),
        "peer_u": nrm(ks[14], (DEPTH, N_EXPERTS, D), D ** -0.5),
        "peer_v": nrm(ks[15], (DEPTH, N_EXPERTS, D), PEER_HEADS ** -0.5),
    }


def reference(x, c, rel_bias, norm1_g, norm2_g, w_ada, b_ada, a_w_in, a_q_gain, a_k_gain,
              b_w_in, w_out, peer_w_query, peer_sub_keys, peer_u, peer_v):
    cs = jax.nn.silu(c)
    h = x
    for i in range(DEPTH):
        mod = cs @ w_ada[i] + b_ada[i]
        sh1, sc1, g1, sh2, sc2, g2 = jnp.split(mod, 6, axis=-1)
        xm = modulate(rms_norm(h, norm1_g[i]), sh1, sc1)
        j = i // N_MIXERS
        if i % N_MIXERS == 0:
            y = dilated_attention(xm, a_w_in[j], a_q_gain[j], a_k_gain[j], rel_bias)
        else:
            y = stick_breaking(xm, b_w_in[j])
        h = h + g1[:, None, :] * (y @ w_out[i])
        xf = modulate(rms_norm(h, norm2_g[i]), sh2, sc2)
        h = h + g2[:, None, :] * peer(xf, peer_w_query[i], peer_sub_keys[i], peer_u[i], peer_v[i])
    return h
```

```cpp
#include <hip/hip_runtime.h>
#include <stdint.h>
#include <stdio.h>

#define LAS __attribute__((address_space(3)))
typedef unsigned short bf16_t;
typedef short bf16x8 __attribute__((ext_vector_type(8)));
typedef short s16x4 __attribute__((ext_vector_type(4)));
typedef float f32x2 __attribute__((ext_vector_type(2)));
typedef float f32x4 __attribute__((ext_vector_type(4)));
typedef float f32x16 __attribute__((ext_vector_type(16)));
typedef unsigned u32x4 __attribute__((ext_vector_type(4)));
typedef unsigned u32x2 __attribute__((ext_vector_type(2)));

constexpr int D = 2048, NBATCH = 2, SEQ = 4096, T = NBATCH * SEQ;
constexpr int NA = 18432, NBP = 6144, NE = 16384, MOD6 = 6 * D;
constexpr float EPS = 1e-6f;

constexpr size_t MB = 1024 * 1024;
constexpr size_t WS_BAR = 0;
constexpr size_t WS_MOD = 16384;
constexpr size_t WS_BIASD = WS_MOD + 2 * 2 * MOD6 * 4;
constexpr size_t WS_WINA = 1 * MB;
constexpr size_t WS_WINB = WS_WINA + (size_t)NA * D * 2;
constexpr size_t WS_WOUT = WS_WINB + (size_t)NBP * D * 2;
constexpr size_t WS_WQ = WS_WOUT + (size_t)2 * D * D * 2;
constexpr size_t WS_KEYS = WS_WQ + (size_t)2 * D * D * 2;
constexpr size_t WS_U = WS_KEYS + (size_t)2 * 8 * 2 * 128 * 128 * 2;
constexpr size_t WS_V = WS_U + (size_t)2 * NE * D * 2;
constexpr size_t WS_XM = WS_V + (size_t)2 * NE * D * 2;
constexpr size_t WS_H1 = WS_XM + (size_t)T * D * 2;
constexpr size_t WS_H2 = WS_H1 + (size_t)T * D * 4;
constexpr size_t WS_OG = WS_H2 + (size_t)T * D * 4;
constexpr size_t WS_LSE = WS_OG + (size_t)3 * T * D * 2;
constexpr size_t WS_QKV = WS_LSE + (size_t)3 * T * 16 * 4;
constexpr size_t WS_Y = WS_QKV + 112 * MB;
constexpr size_t WS_PQ = WS_Y + (size_t)T * D * 2;
constexpr size_t WS_SELI = WS_PQ + (size_t)T * D * 2;
constexpr size_t WS_SELG = WS_SELI + (size_t)T * 128 * 4;
constexpr size_t WS_END = WS_QKV + (size_t)T * NA * 2;
static_assert(WS_SELG + (size_t)T * 128 * 4 <= WS_END, "aliases must fit inside the qkv region");
static_assert(WS_QKV + (size_t)T * NBP * 2 <= WS_Y, "layer-1 qkv must not overlap y");

constexpr int LDS_BYTES = 159 * 1024;

__device__ __forceinline__ unsigned cvt_pk_bf16(float lo, float hi) { unsigned r; asm volatile("v_cvt_pk_bf16_f32 %0, %1, %2" : "=v"(r) : "v"(lo), "v"(hi)); return r; }
__device__ __forceinline__ float bf_lo(unsigned u) { return __uint_as_float(u << 16); }
__device__ __forceinline__ float bf_hi(unsigned u) { return __uint_as_float(u & 0xffff0000u); }
__device__ __forceinline__ bf16_t f2bf(float f) { unsigned u = __float_as_uint(f); u += 0x7FFFu + ((u >> 16) & 1u); return (bf16_t)(u >> 16); }
template <int CTRL> __device__ __forceinline__ float dppf(float x) { return __builtin_bit_cast(float, __builtin_amdgcn_mov_dpp(__builtin_bit_cast(int, x), CTRL, 0xf, 0xf, true)); }
__device__ __forceinline__ float row16_sum(float x) { x += dppf<0xB1>(x); x += dppf<0x4E>(x); x += dppf<0x141>(x); x += dppf<0x140>(x); return x; }
__device__ __forceinline__ float half_swap_sum(float x) { auto t = __builtin_amdgcn_permlane32_swap(__float_as_uint(x), __float_as_uint(x), false, false); return __uint_as_float(t[0]) + __uint_as_float(t[1]); }
__device__ __forceinline__ float half_swap_max(float x) { auto t = __builtin_amdgcn_permlane32_swap(__float_as_uint(x), __float_as_uint(x), false, false); return fmaxf(__uint_as_float(t[0]), __uint_as_float(t[1])); }
__device__ __forceinline__ float wave_sum(float x) { x = row16_sum(x); x += __shfl_xor(x, 16); x = half_swap_sum(x); return x; }
#define XB_TMO      128
#define XB_XCNT(j)  (256  + 64 * (j))
#define XB_XSUB(j)  (1280 + 64 * (j))
#define XB_XGEN(j)  (2304 + 64 * (j))
#define XB_TOP      3328
#define XB_TOPGEN   3392
#define XCD_BAR_WORDS 3456
#define XB_SPIN_CAP (1u << 18)

__device__ __forceinline__ unsigned xb_ld(unsigned* p)              { return __hip_atomic_load(p, __ATOMIC_RELAXED, __HIP_MEMORY_SCOPE_AGENT); }
__device__ __forceinline__ unsigned xb_add(unsigned* p, unsigned v) { return __hip_atomic_fetch_add(p, v, __ATOMIC_RELAXED, __HIP_MEMORY_SCOPE_AGENT); }
__device__ __forceinline__ unsigned xb_xcc_id() { return (unsigned)__builtin_amdgcn_s_getreg((3 << 11) | 20) & 0xFu; }
#define XB_SPIN(cond, bar) do { unsigned _sp = 0; while (cond) { __builtin_amdgcn_s_sleep(1); \
    if ((++_sp & 255u) == 0u) { if (xb_ld(&(bar)[XB_TMO])) break; if (_sp > XB_SPIN_CAP) { atomicAdd(&(bar)[XB_TMO], 1u); break; } } } } while (0)

struct XcdBarrier {
    unsigned* bar; unsigned x;
    volatile LAS unsigned* st;
};

__device__ __forceinline__ XcdBarrier xcd_barrier_post(unsigned* bar, volatile LAS unsigned* st) {
    XcdBarrier b; b.bar = bar; b.x = xb_xcc_id(); b.st = st;
    if (threadIdx.x == 0) (void)xb_add(&bar[XB_XCNT(b.x)], 1u);
    return b;
}
__device__ __forceinline__ void xcd_barrier_complete(unsigned* bar, unsigned x, unsigned& nloc, unsigned& nx) {
    const unsigned G = gridDim.x * gridDim.y * gridDim.z;
    unsigned sum, cnt, mine, sp = 0u;
    for (;;) {
        sum = 0u; cnt = 0u; mine = 0u;
#pragma unroll
        for (unsigned j = 0; j < 16; ++j) { const unsigned c = xb_ld(&bar[XB_XCNT(j)]); sum += c; cnt += (c > 0u) ? 1u : 0u; mine = (j == x) ? c : mine; }
        if (sum == G) break;
        __builtin_amdgcn_s_sleep(1);
        if ((++sp & 255u) == 0u) { if (xb_ld(&bar[XB_TMO])) break; if (sp > XB_SPIN_CAP) { atomicAdd(&bar[XB_TMO], 1u); break; } }
    }
    nloc = mine > 0u ? mine : 1u; nx = cnt > 0u ? cnt : 1u;
}

__device__ __forceinline__ void xcd_barrier(const XcdBarrier& b) {
    asm volatile("s_waitcnt vmcnt(0)" ::: "memory");
    __syncthreads();
    if (threadIdx.x == 0) {
        unsigned* bar = b.bar;
        __builtin_amdgcn_s_waitcnt(0);
        unsigned nloc = b.st[0], nx = b.st[1];
        if (nloc == 0u) { xcd_barrier_complete(bar, b.x, nloc, nx); b.st[0] = nloc; b.st[1] = nx; }
        const unsigned old = xb_add(&bar[XB_XSUB(b.x)], 1u);
        const unsigned gen = old / nloc;
        if (old + 1u == (gen + 1u) * nloc) {
            __builtin_amdgcn_fence(__ATOMIC_RELEASE, "agent");
            asm volatile("s_waitcnt vmcnt(0)" ::: "memory");
            const unsigned og = xb_add(&bar[XB_TOP], 1u);
            const unsigned tg = og / nx;
            if (og + 1u == (tg + 1u) * nx) xb_add(&bar[XB_TOPGEN], 1u);
            else XB_SPIN(xb_ld(&bar[XB_TOPGEN]) == tg, bar);
            __builtin_amdgcn_fence(__ATOMIC_ACQUIRE, "agent");
            xb_add(&bar[XB_XGEN(b.x)], 1u);
            asm volatile("s_waitcnt vmcnt(0)" ::: "memory");
        } else {
            XB_SPIN(xb_ld(&bar[XB_XGEN(b.x)]) == gen, bar);
            __builtin_amdgcn_fence(__ATOMIC_ACQUIRE, "agent");
            asm volatile("s_waitcnt vmcnt(0)" ::: "memory");
        }
    }
    __syncthreads();
}
namespace pg8 {
#define PG8_LAS __attribute__((address_space(3)))
constexpr int BM = 256, BK = 64, HALF = 128, HTB = HALF * BK * 2  , STAGE_BYTES = 8 * HTB, NXCD = 8, WGM = 8;

__host__ __device__ __forceinline__ int lds_byte(int r, int c) { const int st = (r >> 4) * 2 + (c >> 5), rr = r & 15, cc = c & 31, ob = rr * 64 + cc * 2; return st * 1024 + (ob ^ (((ob >> 9) & 1) << 5)); }
__host__ __device__ __forceinline__ void stage_rc(int b, int& R, int& C) { const int st = b / 1024, sb = b % 1024, swz = sb ^ (((sb >> 9) & 1) << 5); R = (st >> 1) * 16 + swz / 64; C = (st & 1) * 32 + (swz % 64) / 2; }
__host__ __device__ __forceinline__ int perm32(int rho) { const int n = rho >> 4, i = rho & 15; return 8 * (i >> 2) + 4 * n + (i & 3); }

struct Unit { int pm, pn; };
struct Gemm { const bf16_t* A; const bf16_t* Bt; int M, N, K; };

struct StaticOrder {
    int nM, nN, nwg, G, c;
    __host__ __device__ void init(int M, int N, int G_, int c_) { nM = M / BM; nN = N / BM; nwg = nM * nN; G = G_; c = c_; }
    __host__ __device__ bool next(int i, Unit& u) const {
        const long L = (long)i * G + c; if (L >= nwg) return false;
        int wgid = (int)L; { const int q = nwg / NXCD, r = nwg % NXCD, xcd = wgid % NXCD, off = wgid / NXCD; wgid = (xcd < r ? xcd * (q + 1) : r * (q + 1) + (xcd - r) * q) + off; }
        const int nig = WGM * nN, gid = wgid / nig, fm = gid * WGM, gsz = (nM - fm) < WGM ? (nM - fm) : WGM;
        u.pm = fm + ((wgid % nig) % gsz); u.pn = (wgid % nig) / gsz; return true;
    }
    __device__ __forceinline__ void a_ready(const Unit&) const {}
    __device__ __forceinline__ void done(const Unit&) const {}
};

template <class Epi, class Sched>
__device__ __forceinline__ void gemm_phase(PG8_LAS unsigned char* lds, const Gemm g, const Sched& S, const Epi& E) {
    const int tid = threadIdx.x, wid = __builtin_amdgcn_readfirstlane(tid >> 6), lane = tid & 63, wr = wid >> 2, wc = wid & 3, fr = lane & 15, fq = lane >> 4;
    const int K = g.K, nt = K / BK;
    unsigned voffA[2], voffB[2];
#pragma unroll
    for (int i = 0; i < 2; ++i) { int R, C; stage_rc(tid * 16 + i * 8192, R, C); const int Rb = Epi::PERM ? ((R & ~31) + perm32(R & 31)) : R;
        voffA[i] = (unsigned)(R * K + C) * 2u; voffB[i] = (unsigned)(Rb * K + C) * 2u; }
    const size_t kstep = (size_t)(BK * 2);
    const size_t hstep = (size_t)HALF * K * 2;
    const size_t tstep = 2 * hstep;
    const unsigned ldsw = (unsigned)wid * 1024u;
    const int aoff = lds_byte(wr * 64 + fr, fq * 8), boff = lds_byte(wc * 32 + fr, fq * 8);
#define PG8_SA(b, h) (((b) * 2 + (h)) * HTB)
#define PG8_SB(b, h) ((4 + (b) * 2 + (h)) * HTB)
#define PG8_STAGE(bufoff, gbase, voff) do { _Pragma("unroll") for (int _i = 0; _i < 2; ++_i) \
        __builtin_amdgcn_global_load_lds((const unsigned*)((const char*)(gbase) + (voff)[_i]), (PG8_LAS unsigned*)(lds + (bufoff) + ldsw + _i * 8192), 16, 0, 0); } while (0)
#define PG8_LDA(dst, b, h) do { _Pragma("unroll") for (int m = 0; m < 4; ++m) _Pragma("unroll") for (int k = 0; k < 2; ++k) dst[m][k] = *(const PG8_LAS bf16x8*)(lds + PG8_SA(b, h) + aoff + m * 2048 + k * 1024); } while (0)
#define PG8_LDB(dst, b, h) do { _Pragma("unroll") for (int n = 0; n < 2; ++n) _Pragma("unroll") for (int k = 0; k < 2; ++k) dst[n][k] = *(const PG8_LAS bf16x8*)(lds + PG8_SB(b, h) + boff + n * 2048 + k * 1024); } while (0)
#define PG8_MMA(ai, bj, At, Bt) do { __builtin_amdgcn_s_setprio(1); _Pragma("unroll") for (int m = 0; m < 4; ++m) _Pragma("unroll") for (int n = 0; n < 2; ++n) _Pragma("unroll") for (int k = 0; k < 2; ++k) \
        acc[ai][bj][m][n] = __builtin_amdgcn_mfma_f32_16x16x32_bf16(Bt[n][k], At[m][k], acc[ai][bj][m][n], 0, 0, 0); __builtin_amdgcn_s_setprio(0); } while (0)
#define PG8_WAIT_V(n) asm volatile("s_waitcnt vmcnt(" #n ")" ::: "memory")
#define PG8_WAIT_L(n) asm volatile("s_waitcnt lgkmcnt(" #n ")" ::: "memory")
#define PG8_BAR __builtin_amdgcn_s_barrier()
#define PG8_SCHED __builtin_amdgcn_sched_barrier(0)
    Unit cur, nxt; int ui = 0;
    if (!S.next(0, cur)) return;
    f32x4 acc[2][2][4][2];
#pragma unroll
    for (int a = 0; a < 2; ++a)
#pragma unroll
        for (int b = 0; b < 2; ++b)
#pragma unroll
            for (int m = 0; m < 4; ++m)
#pragma unroll
                for (int n = 0; n < 2; ++n) acc[a][b][m][n] = (f32x4){0.f, 0.f, 0.f, 0.f};
    bf16x8 At[4][2], B0[2][2], B1[2][2];
    const char* cA = (const char*)g.A + (size_t)cur.pm * tstep; const char* cB = (const char*)g.Bt + (size_t)cur.pn * tstep;
    S.a_ready(cur);
    PG8_STAGE(PG8_SB(0, 0), cB, voffB); PG8_STAGE(PG8_SA(0, 0), cA, voffA); PG8_STAGE(PG8_SB(0, 1), cB + hstep, voffB); PG8_STAGE(PG8_SA(0, 1), cA + hstep, voffA);
    if (wr == 1) PG8_BAR;
    PG8_WAIT_V(4); PG8_BAR;
    PG8_STAGE(PG8_SB(1, 0), cB + kstep, voffB); PG8_STAGE(PG8_SA(1, 0), cA + kstep, voffA); PG8_STAGE(PG8_SB(1, 1), cB + hstep + kstep, voffB);
    PG8_WAIT_V(6); PG8_BAR;
    for (;;) {
        const bool has_next = S.next(ui + 1, nxt);
        const char* nA = has_next ? (const char*)g.A + (size_t)nxt.pm * tstep : cA; const char* nB = has_next ? (const char*)g.Bt + (size_t)nxt.pn * tstep : cB;
        for (int t = 0; t < nt; t += 2) {
            const bool last = (t == nt - 2);
            const char* a1 = cA + (size_t)(t + 1) * kstep;
            const char* a2 = last ? nA : cA + (size_t)(t + 2) * kstep; const char* b2 = last ? nB : cB + (size_t)(t + 2) * kstep;
            const char* a3 = a2 + kstep; const char* b3 = b2 + kstep;
            if (last && has_next) S.a_ready(nxt);
            PG8_LDB(B0, 0, 0); PG8_SCHED; PG8_LDA(At, 0, 0); PG8_STAGE(PG8_SA(1, 1), a1 + hstep, voffA);
            PG8_WAIT_L(8); PG8_BAR; PG8_WAIT_L(0); PG8_MMA(0, 0, At, B0); PG8_BAR; PG8_SCHED;
            PG8_LDB(B1, 0, 1); PG8_STAGE(PG8_SB(0, 0), b2, voffB);
            PG8_BAR; PG8_WAIT_L(0); PG8_MMA(0, 1, At, B1); PG8_BAR;
            PG8_LDA(At, 0, 1); PG8_STAGE(PG8_SA(0, 0), a2, voffA);
            PG8_BAR; PG8_WAIT_L(0); PG8_MMA(1, 0, At, B0); PG8_BAR; PG8_SCHED;
            PG8_STAGE(PG8_SB(0, 1), b2 + hstep, voffB);
            PG8_WAIT_V(6); PG8_BAR; PG8_MMA(1, 1, At, B1); PG8_BAR;
            PG8_LDB(B0, 1, 0); PG8_SCHED; PG8_LDA(At, 1, 0); PG8_STAGE(PG8_SA(0, 1), a2 + hstep, voffA);
            PG8_WAIT_L(8); PG8_BAR; PG8_WAIT_L(0); PG8_MMA(0, 0, At, B0); PG8_BAR; PG8_SCHED;
            PG8_LDB(B1, 1, 1); PG8_STAGE(PG8_SB(1, 0), b3, voffB);
            PG8_BAR; PG8_WAIT_L(0); PG8_MMA(0, 1, At, B1); PG8_BAR;
            PG8_LDA(At, 1, 1); PG8_STAGE(PG8_SA(1, 0), a3, voffA);
            PG8_BAR; PG8_WAIT_L(0); PG8_MMA(1, 0, At, B0); PG8_BAR; PG8_SCHED;
            PG8_STAGE(PG8_SB(1, 1), b3 + hstep, voffB);
            PG8_WAIT_V(6); PG8_BAR; PG8_MMA(1, 1, At, B1); PG8_BAR;
        }
        if constexpr (!Epi::AFTER_DRAIN) { E(acc, cur, wr, wc, fr, fq); S.done(cur); }
        if (!has_next) break;
#pragma unroll
        for (int a = 0; a < 2; ++a)
#pragma unroll
            for (int b = 0; b < 2; ++b)
#pragma unroll
                for (int m = 0; m < 4; ++m)
#pragma unroll
                    for (int n = 0; n < 2; ++n) acc[a][b][m][n] = (f32x4){0.f, 0.f, 0.f, 0.f};
        cur = nxt; cA = nA; cB = nB; ++ui;
    }
    PG8_WAIT_V(0);
    if (wr == 0) PG8_BAR;
    PG8_BAR;
    if constexpr (Epi::AFTER_DRAIN) { E.fused(acc, cur, wr, wc, fr, fq, lds, wid, lane); S.done(cur); }
#undef PG8_SA
#undef PG8_SB
#undef PG8_STAGE
#undef PG8_LDA
#undef PG8_LDB
#undef PG8_MMA
#undef PG8_WAIT_V
#undef PG8_WAIT_L
#undef PG8_BAR
#undef PG8_SCHED
}
}
namespace pg8 {
struct EpiStoreBf16 {
    static constexpr bool PERM = true, AFTER_DRAIN = false;
    bf16_t* O; int ldc;
    __device__ __forceinline__ void operator()(const f32x4 (&acc)[2][2][4][2], const Unit& u, int wr, int wc, int fr, int fq) const {
        const int row0 = u.pm * BM + wr * 64 + fr, col0 = u.pn * BM + wc * 32 + 8 * fq;
#pragma unroll
        for (int ai = 0; ai < 2; ++ai)
#pragma unroll
            for (int m = 0; m < 4; ++m) { bf16_t* rowp = O + (size_t)(row0 + ai * HALF + m * 16) * ldc + col0;
#pragma unroll
                for (int bj = 0; bj < 2; ++bj) { const f32x4 v0 = acc[ai][bj][m][0], v1 = acc[ai][bj][m][1];
                    u32x4 o; o[0] = cvt_pk_bf16(v0[0], v0[1]); o[1] = cvt_pk_bf16(v0[2], v0[3]); o[2] = cvt_pk_bf16(v1[0], v1[1]); o[3] = cvt_pk_bf16(v1[2], v1[3]);
                    *(u32x4*)(rowp + bj * HALF) = o; } }
    }
};
struct EpiResGate {
    static constexpr bool PERM = false, AFTER_DRAIN = false;
    const float* Hin; float* Hout; const float* gate;
    __device__ __forceinline__ void operator()(const f32x4 (&acc)[2][2][4][2], const Unit& u, int wr, int wc, int fr, int fq) const {
        const int row0 = u.pm * BM + wr * 64 + fr, col0 = u.pn * BM + wc * 32 + 4 * fq;
        const float* gp = gate + (size_t)(u.pm >> 4) * MOD6 + col0;
        f32x4 gv[2][2];
#pragma unroll
        for (int bj = 0; bj < 2; ++bj)
#pragma unroll
            for (int n = 0; n < 2; ++n) gv[bj][n] = *(const f32x4*)(gp + bj * HALF + n * 16);
#pragma unroll
        for (int ai = 0; ai < 2; ++ai)
#pragma unroll
            for (int m = 0; m < 4; ++m) { const size_t ro = (size_t)(row0 + ai * HALF + m * 16) * D + col0;
#pragma unroll
                for (int bj = 0; bj < 2; ++bj)
#pragma unroll
                    for (int n = 0; n < 2; ++n) { const f32x4 h = *(const f32x4*)(Hin + ro + bj * HALF + n * 16);
                        *(f32x4*)(Hout + ro + bj * HALF + n * 16) = h + gv[bj][n] * acc[ai][bj][m][n]; } }
    }
};
}

struct Params {
    const float *x, *c, *rel_bias, *norm1_g, *norm2_g, *w_ada, *b_ada, *a_w_in, *a_q_gain, *a_k_gain, *b_w_in, *w_out, *peer_wq, *peer_keys, *peer_u, *peer_v;
    float* out; unsigned char* ws; int ph_lo, ph_hi;
};
struct Ctx { LAS unsigned char* lds; int tid, lane, wave, G, bid; };

__device__ __forceinline__ void p0_transpose(const Ctx& C, const Params& P) {
    bf16_t* WinA = (bf16_t*)(P.ws + WS_WINA); bf16_t* WinB = (bf16_t*)(P.ws + WS_WINB); bf16_t* Wout = (bf16_t*)(P.ws + WS_WOUT); bf16_t* Wq = (bf16_t*)(P.ws + WS_WQ);
    LAS bf16_t* tile = (LAS bf16_t*)C.lds;
    const int kr = C.tid >> 4, cg = C.tid & 15, wn = C.tid >> 3, wk = C.tid & 7;
    for (int ti = C.bid; ti < 16384; ti += C.G) {
        const float* src; bf16_t* dst; int N; int loc = ti;
        if (loc < 9216) { src = P.a_w_in; dst = WinA; N = NA; }
        else if (loc < 9216 + 3072) { loc -= 9216; src = P.b_w_in; dst = WinB; N = NBP; }
        else { loc -= 9216 + 3072; const int m = loc >> 10; loc &= 1023; N = D;
               src = (m < 2) ? P.w_out + (size_t)m * D * D : P.peer_wq + (size_t)(m - 2) * D * D; dst = (m < 2) ? Wout + (size_t)m * D * D : Wq + (size_t)(m - 2) * D * D; }
        const int ntl = N >> 6, kt = loc / ntl, nt = loc - kt * ntl, k0 = kt * 64, n0 = nt * 64;
#pragma unroll
        for (int i = 0; i < 2; ++i) { const f32x4 v = *(const f32x4*)(src + (size_t)(k0 + kr + 32 * i) * N + n0 + 4 * cg);
#pragma unroll
            for (int j = 0; j < 4; ++j) tile[(4 * cg + j) * 72 + kr + 32 * i] = f2bf(v[j]); }
        __syncthreads();
        { const u32x4 v = *(const LAS u32x4*)(tile + wn * 72 + 8 * wk); *(u32x4*)(dst + (size_t)(n0 + wn) * D + k0 + 8 * wk) = v; }
        __syncthreads();
    }
}
__device__ __forceinline__ void p0_convert(const Ctx& C, const float* src, bf16_t* dst, size_t n) {
    const size_t stride = (size_t)C.G * 512 * 8;
    for (size_t i = ((size_t)C.bid * 512 + C.tid) * 8; i < n; i += stride) {
        const f32x4 a = *(const f32x4*)(src + i), b = *(const f32x4*)(src + i + 4);
        u32x4 o; o[0] = cvt_pk_bf16(a[0], a[1]); o[1] = cvt_pk_bf16(a[2], a[3]); o[2] = cvt_pk_bf16(b[0], b[1]); o[3] = cvt_pk_bf16(b[2], b[3]);
        *(u32x4*)(dst + i) = o; }
}
__device__ __forceinline__ void p0_ada(const Ctx& C, const Params& P) {
    float* mod = (float*)(P.ws + WS_MOD);
    LAS float* red = (LAS float*)C.lds;
    const int cgp = C.tid % 24, ks = C.tid / 24;
    for (int cb = C.bid; cb < 256; cb += C.G) {
        const int l = cb >> 7, col0 = (cb & 127) * 96;
        if (ks < 21) {
            f32x4 a0 = {0.f, 0.f, 0.f, 0.f}, a1 = {0.f, 0.f, 0.f, 0.f};
            const float* wp = P.w_ada + (size_t)l * D * MOD6 + col0 + 4 * cgp;
            for (int k = ks; k < D; k += 21) {
                const f32x4 w = *(const f32x4*)(wp + (size_t)k * MOD6);
                const float c0 = P.c[k], c1 = P.c[D + k];
                const float s0 = c0 / (1.f + __expf(-c0)), s1 = c1 / (1.f + __expf(-c1));
                a0 += w * s0; a1 += w * s1; }
            *(LAS f32x4*)(red + (ks * 2 + 0) * 96 + 4 * cgp) = a0; *(LAS f32x4*)(red + (ks * 2 + 1) * 96 + 4 * cgp) = a1;
        }
        __syncthreads();
        if (C.tid < 192) { const int b = C.tid / 96, j = C.tid % 96; float s = P.b_ada[(size_t)l * MOD6 + col0 + j];
            for (int q = 0; q < 21; ++q) s += red[(q * 2 + b) * 96 + j];
            mod[((size_t)l * 2 + b) * MOD6 + col0 + j] = s; }
        __syncthreads();
    }
}
__device__ __forceinline__ void p0_bias(const Ctx& C, const Params& P) {
    float* biasd = (float*)(P.ws + WS_BIASD);
    if (C.bid == (C.G > 1 ? 1 : 0)) {
        for (int i = C.tid; i < 3 * 16 * 129; i += 512) {
            const int delta = i % 129, gh = i / 129, h = gh & 15, g = gh >> 4;
            const int dil = (g == 0) ? 1 : (g == 1 ? 4 : 16), dist = delta * dil;
            int bucket;
            if (dist < 16) bucket = dist;
            else { const float df = (float)dist; const int lb = 16 + (int)(logf(df / 16.f) / logf(128.f) * 16.f); bucket = lb < 31 ? lb : 31; }
            biasd[(size_t)gh * 132 + delta] = P.rel_bias[bucket * 48 + g * 16 + h]; }
    }
}
__device__ __forceinline__ void p0_prologue(const Ctx& C, const Params& P) {
    p0_ada(C, P);
    p0_bias(C, P);
    p0_transpose(C, P);
    p0_convert(C, P.peer_keys, (bf16_t*)(P.ws + WS_KEYS), (size_t)2 * 8 * 2 * 128 * 128);
    p0_convert(C, P.peer_u, (bf16_t*)(P.ws + WS_U), (size_t)2 * NE * D);
    p0_convert(C, P.peer_v, (bf16_t*)(P.ws + WS_V), (size_t)2 * NE * D);
}

__device__ __forceinline__ void norm_mod_phase(const Ctx& C, const float* hin, const float* gain, const float* shift, const float* scale, bf16_t* out) {
    const int gw = C.bid * 8 + C.wave, nw = C.G * 8;
    for (int row = gw; row < T; row += nw) {
        const int b = row >> 12;
        const float* hp = hin + (size_t)row * D;
        f32x4 v[8]; float ss = 0.f;
#pragma unroll
        for (int j = 0; j < 8; ++j) { v[j] = *(const f32x4*)(hp + (C.lane + 64 * j) * 4); ss += v[j][0] * v[j][0] + v[j][1] * v[j][1] + v[j][2] * v[j][2] + v[j][3] * v[j][3]; }
        ss = wave_sum(ss);
        const float r = rsqrtf(ss * (1.f / D) + EPS);
#pragma unroll
        for (int j = 0; j < 8; ++j) { const int col = (C.lane + 64 * j) * 4;
            const f32x4 g = *(const f32x4*)(gain + col), sh = *(const f32x4*)(shift + (size_t)b * MOD6 + col), sc = *(const f32x4*)(scale + (size_t)b * MOD6 + col);
            const f32x4 y = (v[j] * r * g) * (sc + 1.f) + sh;
            u32x2 o; o[0] = cvt_pk_bf16(y[0], y[1]); o[1] = cvt_pk_bf16(y[2], y[3]);
            *(u32x2*)(out + (size_t)row * D + col) = o; }
    }
}
constexpr int KP = 272, VP = 320;
constexpr int AW_K = 0, AW_V = 32 * KP, AW_BIAS = AW_V + 32 * VP, AW_BYTES = AW_BIAS + 544;
static_assert(AW_BYTES * 8 <= LDS_BYTES, "attention LDS");

__device__ __forceinline__ void tile_load(u32x4 (&r)[8], const bf16_t* base, size_t row_stride, int lane) {
#pragma unroll
    for (int c = 0; c < 8; ++c) r[c] = *(const u32x4*)(base + (size_t)((lane >> 4) + 4 * c) * row_stride + (lane & 15) * 8);
}
__device__ __forceinline__ void tile_write(LAS unsigned char* dst, int pitch, const u32x4 (&r)[8], int lane) {
#pragma unroll
    for (int c = 0; c < 8; ++c) *(LAS u32x4*)(dst + ((lane >> 4) + 4 * c) * pitch + (lane & 15) * 16) = r[c];
}
__device__ __forceinline__ void tile_rownorm(u32x4 (&r)[8], const float (&gn)[8]) {
#pragma unroll
    for (int c = 0; c < 8; ++c) {
        float v[8];
#pragma unroll
        for (int j = 0; j < 4; ++j) { v[2 * j] = bf_lo(r[c][j]); v[2 * j + 1] = bf_hi(r[c][j]); }
        float ss = 0.f;
#pragma unroll
        for (int j = 0; j < 8; ++j) ss += v[j] * v[j];
        ss = row16_sum(ss);
        const float sc = rsqrtf(ss * (1.f / 128.f) + EPS);
#pragma unroll
        for (int j = 0; j < 4; ++j) r[c][j] = cvt_pk_bf16(v[2 * j] * sc * gn[2 * j], v[2 * j + 1] * sc * gn[2 * j + 1]);
    }
}
__device__ __forceinline__ f32x16 qk_tile(const LAS unsigned char* Kl, const bf16x8 (&qf)[8], int r32, int hh) {
    f32x16 S;
#pragma unroll
    for (int i = 0; i < 16; ++i) S[i] = 0.f;
#pragma unroll
    for (int s = 0; s < 8; ++s) { const bf16x8 a = *(const LAS bf16x8*)(Kl + r32 * KP + (16 * s + 8 * hh) * 2); S = __builtin_amdgcn_mfma_f32_32x32x16_bf16(a, qf[s], S, 0, 0, 0); }
    return S;
}
__device__ __forceinline__ void pv_tile(f32x16 (&O)[4], const LAS unsigned char* Vl, const f32x16& Pm, int lane) {
    bf16x8 pf[2];
#pragma unroll
    for (int s = 0; s < 2; ++s) {
        u32x4 w;
#pragma unroll
        for (int j = 0; j < 4; ++j) w[j] = cvt_pk_bf16(Pm[8 * s + 2 * j], Pm[8 * s + 2 * j + 1]);
        pf[s] = __builtin_bit_cast(bf16x8, w); }
    const int gi = lane >> 4, hh = gi >> 1, eh = gi & 1, q = (lane >> 2) & 3, p = lane & 3;
    const LAS unsigned char* vb = Vl + (4 * hh + q) * VP + (16 * eh + 4 * p) * 2;
#pragma unroll
    for (int mt = 0; mt < 4; ++mt)
#pragma unroll
        for (int s = 0; s < 2; ++s) {
            const s16x4 lo = __builtin_amdgcn_ds_read_tr16_b64_v4i16((LAS s16x4*)(vb + s * 16 * VP + mt * 64));
            const s16x4 hi = __builtin_amdgcn_ds_read_tr16_b64_v4i16((LAS s16x4*)(vb + s * 16 * VP + 8 * VP + mt * 64));
            const bf16x8 a = {lo[0], lo[1], lo[2], lo[3], hi[0], hi[1], hi[2], hi[3]};
            O[mt] = __builtin_amdgcn_mfma_f32_32x32x16_bf16(a, pf[s], O[mt], 0, 0, 0); }
}
__device__ __forceinline__ void store_ot(bf16_t* out_row, const f32x16 (&O)[4], float scale, int hh) {
#pragma unroll
    for (int mt = 0; mt < 4; ++mt)
#pragma unroll
        for (int q4 = 0; q4 < 4; ++q4) { u32x2 o; o[0] = cvt_pk_bf16(O[mt][4 * q4] * scale, O[mt][4 * q4 + 1] * scale); o[1] = cvt_pk_bf16(O[mt][4 * q4 + 2] * scale, O[mt][4 * q4 + 3] * scale);
            *(u32x2*)(out_row + 32 * mt + 8 * q4 + 4 * hh) = o; }
}

__device__ __forceinline__ void attn_dilated_phase(const Ctx& C, const Params& P) {
    const bf16_t* qkv = (const bf16_t*)(P.ws + WS_QKV); bf16_t* og = (bf16_t*)(P.ws + WS_OG); float* lse = (float*)(P.ws + WS_LSE);
    const float* biasd = (const float*)(P.ws + WS_BIASD);
    LAS unsigned char* wl = C.lds + C.wave * AW_BYTES; LAS unsigned char* Kl = wl + AW_K; LAS unsigned char* Vl = wl + AW_V; LAS float* Bl = (LAS float*)(wl + AW_BIAS);
    const int lane = C.lane, r32 = lane & 31, hh = lane >> 5;
    const int nw = C.G * 8;
    for (int item = C.bid * 8 + C.wave; item < 3 * 4096; item += nw) {
        const int g = item >> 12, b = (item >> 11) & 1, h = (item >> 7) & 15, rj = item & 127;
        const int lg = 2 * g, dil = 1 << lg;
        const int njt = 128 >> lg, r = rj / njt, j = rj - r * njt;
        const size_t tok0 = (size_t)b * SEQ + r;
        const bf16_t* qbase = qkv + (size_t)g * 6144 + h * 128;
        for (int i = lane; i < 132; i += 64) Bl[i] = (i < 129) ? biasd[(size_t)(g * 16 + h) * 132 + i] : 0.f;
        bf16x8 qf[8];
        {
            const bf16_t* qp = qbase + (tok0 + (size_t)(32 * j + r32) * dil) * NA + 8 * hh;
            u32x4 raw[8]; float ss = 0.f;
#pragma unroll
            for (int s = 0; s < 8; ++s) { raw[s] = *(const u32x4*)(qp + 16 * s);
#pragma unroll
                for (int k = 0; k < 4; ++k) { const float a = bf_lo(raw[s][k]), c = bf_hi(raw[s][k]); ss += a * a + c * c; } }
            ss = half_swap_sum(ss);
            const float sc = rsqrtf(ss * (1.f / 128.f) + EPS) * 0.08838834764831845f;
            const float* gq = P.a_q_gain + g * 128 + 8 * hh;
#pragma unroll
            for (int s = 0; s < 8; ++s) { const f32x4 g0 = *(const f32x4*)(gq + 16 * s), g1 = *(const f32x4*)(gq + 16 * s + 4);
                u32x4 w;
                w[0] = cvt_pk_bf16(bf_lo(raw[s][0]) * sc * g0[0], bf_hi(raw[s][0]) * sc * g0[1]); w[1] = cvt_pk_bf16(bf_lo(raw[s][1]) * sc * g0[2], bf_hi(raw[s][1]) * sc * g0[3]);
                w[2] = cvt_pk_bf16(bf_lo(raw[s][2]) * sc * g1[0], bf_hi(raw[s][2]) * sc * g1[1]); w[3] = cvt_pk_bf16(bf_lo(raw[s][3]) * sc * g1[2], bf_hi(raw[s][3]) * sc * g1[3]);
                qf[s] = __builtin_bit_cast(bf16x8, w); }
        }
        float gk[8];
        { const float* gp = P.a_k_gain + g * 128 + 8 * (lane & 15); const f32x4 a = *(const f32x4*)gp, c = *(const f32x4*)(gp + 4);
          gk[0] = a[0]; gk[1] = a[1]; gk[2] = a[2]; gk[3] = a[3]; gk[4] = c[0]; gk[5] = c[1]; gk[6] = c[2]; gk[7] = c[3]; }
        f32x16 O[4];
#pragma unroll
        for (int mt = 0; mt < 4; ++mt)
#pragma unroll
            for (int i = 0; i < 16; ++i) O[mt][i] = 0.f;
        float m = -1e30f, l = 0.f;
        const int i0 = (j >= 4) ? 0 : 4 - j;
        for (int i = i0; i < 5; ++i) {
            const int lk0 = 32 * (j - 4 + i);
            const bf16_t* kp = qbase + 2048 + (tok0 + (size_t)lk0 * dil) * NA;
            u32x4 kr[8], vr[8];
            tile_load(kr, kp, (size_t)dil * NA, lane); tile_load(vr, kp + 2048, (size_t)dil * NA, lane);
            tile_rownorm(kr, gk);
            tile_write(Kl, KP, kr, lane); tile_write(Vl, VP, vr, lane);
            f32x16 S = qk_tile(Kl, qf, r32, hh);
            const int dbase = 128 - 32 * i + r32;
            float mx = -1e30f;
#pragma unroll
            for (int c = 0; c < 16; ++c) { const int kk = (c & 3) + 8 * (c >> 2) + 4 * hh, delta = dbase - kk;
                const bool ok = (delta >= 0) && (delta <= 128);
                const float bv = Bl[ok ? delta : 0];
                const float v = ok ? S[c] + bv : -1e30f; S[c] = v; mx = fmaxf(mx, v); }
            mx = half_swap_max(mx);
            const float mn = fmaxf(m, mx), alpha = __expf(m - mn);
            float rs = 0.f;
#pragma unroll
            for (int c = 0; c < 16; ++c) { const float p = __expf(S[c] - mn); S[c] = p; rs += p; }
            rs = half_swap_sum(rs);
            l = l * alpha + rs; m = mn;
#pragma unroll
            for (int mt = 0; mt < 4; ++mt)
#pragma unroll
                for (int c = 0; c < 16; ++c) O[mt][c] *= alpha;
            pv_tile(O, Vl, S, lane);
        }
        const size_t tq = tok0 + (size_t)(32 * j + r32) * dil;
        store_ot(og + ((size_t)g * T + tq) * D + h * 128, O, 1.f / l, hh);
        if (hh == 0) lse[((size_t)g * T + tq) * 16 + h] = m + __logf(l);
    }
}

__device__ __forceinline__ void combine_phase(const Ctx& C, const Params& P) {
    const bf16_t* og = (const bf16_t*)(P.ws + WS_OG); const float* lse = (const float*)(P.ws + WS_LSE); bf16_t* y = (bf16_t*)(P.ws + WS_Y);
    const size_t n8 = (size_t)T * D / 8, stride = (size_t)C.G * 512;
    for (size_t i = (size_t)C.bid * 512 + C.tid; i < n8; i += stride) {
        const size_t t = i >> 8; const int h = (int)(i & 255) >> 4;
        const float l0 = lse[(0 * (size_t)T + t) * 16 + h], l1 = lse[(1 * (size_t)T + t) * 16 + h], l2 = lse[(2 * (size_t)T + t) * 16 + h];
        const float mx = fmaxf(l0, fmaxf(l1, l2)); const float e0 = __expf(l0 - mx), e1 = __expf(l1 - mx), e2 = __expf(l2 - mx), inv = 1.f / (e0 + e1 + e2);
        const float a0 = e0 * inv, a1 = e1 * inv, a2 = e2 * inv;
        const u32x4 v0 = *(const u32x4*)(og + i * 8), v1 = *(const u32x4*)(og + (size_t)T * D + i * 8), v2 = *(const u32x4*)(og + 2 * (size_t)T * D + i * 8);
        u32x4 o;
#pragma unroll
        for (int k = 0; k < 4; ++k) o[k] = cvt_pk_bf16(a0 * bf_lo(v0[k]) + a1 * bf_lo(v1[k]) + a2 * bf_lo(v2[k]), a0 * bf_hi(v0[k]) + a1 * bf_hi(v1[k]) + a2 * bf_hi(v2[k]));
        *(u32x4*)(y + i * 8) = o; }
}

constexpr float SB_STOP = 110.f;
__device__ __forceinline__ void attn_stick_phase(const Ctx& C, const Params& P) {
    const bf16_t* qkv = (const bf16_t*)(P.ws + WS_QKV); bf16_t* y = (bf16_t*)(P.ws + WS_Y);
    LAS unsigned char* wl = C.lds + C.wave * AW_BYTES; LAS unsigned char* Kl = wl + AW_K; LAS unsigned char* Vl = wl + AW_V;
    const int lane = C.lane, r32 = lane & 31, hh = lane >> 5;
    const int nw = C.G * 8;
    for (int item = C.bid * 8 + C.wave; item < 4096; item += nw) {
        const int b = item >> 11, h = (item >> 7) & 15, qt = item & 127;
        const bf16_t* base = qkv + (size_t)b * SEQ * NBP + h * 128;
        bf16x8 qf[8];
        { const bf16_t* qp = base + (size_t)(32 * qt + r32) * NBP + 8 * hh;
#pragma unroll
          for (int s = 0; s < 8; ++s) { const u32x4 raw = *(const u32x4*)(qp + 16 * s); u32x4 w;
#pragma unroll
              for (int k = 0; k < 4; ++k) w[k] = cvt_pk_bf16(bf_lo(raw[k]) * 0.08838834764831845f, bf_hi(raw[k]) * 0.08838834764831845f);
              qf[s] = __builtin_bit_cast(bf16x8, w); } }
        f32x16 O[4];
#pragma unroll
        for (int mt = 0; mt < 4; ++mt)
#pragma unroll
            for (int i = 0; i < 16; ++i) O[mt][i] = 0.f;
        float carry = 0.f;
        for (int kt = qt; kt >= 0; --kt) {
            const bf16_t* kp = base + 2048 + (size_t)(32 * kt) * NBP;
            u32x4 kr[8], vr[8];
            tile_load(kr, kp, NBP, lane); tile_load(vr, kp + 2048, NBP, lane);
            tile_write(Kl, KP, kr, lane); tile_write(Vl, VP, vr, lane);
            f32x16 S = qk_tile(Kl, qf, r32, hh);
            const int lim = (kt == qt) ? r32 : 32;
            float sp[16], cs[4];
#pragma unroll
            for (int q4 = 0; q4 < 4; ++q4) { cs[q4] = 0.f;
#pragma unroll
                for (int e = 0; e < 4; ++e) { const int c = 4 * q4 + e, kk = e + 8 * q4 + 4 * hh; const float z = S[c];
                    const float s = (kk < lim) ? fmaxf(z, 0.f) + __logf(1.f + __expf(-fabsf(z))) : 0.f; sp[c] = s; cs[q4] += s; } }
            float pcs[4];
#pragma unroll
            for (int q4 = 0; q4 < 4; ++q4) { auto t2 = __builtin_amdgcn_permlane32_swap(__float_as_uint(cs[q4]), __float_as_uint(cs[q4]), false, false);
                pcs[q4] = hh ? __uint_as_float(t2[0]) : __uint_as_float(t2[1]); }
            float after = carry;
#pragma unroll
            for (int q4 = 3; q4 >= 0; --q4) {
                const float aft_chunk = after + (hh ? 0.f : pcs[q4]);
                float run = aft_chunk;
#pragma unroll
                for (int e = 3; e >= 0; --e) { const int c = 4 * q4 + e, kk = e + 8 * q4 + 4 * hh; const float z = S[c];
                    const float a = (kk < lim) ? __expf(z - sp[c] - run) : 0.f; run += sp[c]; S[c] = a; }
                after += cs[q4] + pcs[q4];
            }
            carry = after;
            pv_tile(O, Vl, S, lane);
            if (__all(carry >= SB_STOP)) break;
        }
        store_ot(y + ((size_t)b * SEQ + 32 * qt + r32) * D + h * 128, O, 1.f, hh);
    }
}
__device__ __forceinline__ int okey(float v, unsigned tag, unsigned tagmask) {
    const unsigned b = (__float_as_uint(v) & ~tagmask) | tag; return (int)(b ^ ((unsigned)((int)b >> 31) & 0x7fffffffu)); }
__device__ __forceinline__ unsigned okey_bits(int k) { const unsigned b = (unsigned)k; return b ^ ((unsigned)(k >> 31) & 0x7fffffffu); }
#define CE_DESC(a, b) do { const int _mx = max(a, b), _mn = min(a, b); a = _mx; b = _mn; } while (0)
template <int N, int B> __device__ __forceinline__ void sort16_desc(int (&k)[N]) {
#pragma unroll
    for (int size = 2; size <= 16; size <<= 1)
#pragma unroll
        for (int stride = size >> 1; stride > 0; stride >>= 1)
#pragma unroll
            for (int i = 0; i < 16; ++i) { const int j = i ^ stride;
                if (j > i) { if ((i & size) == 0) { CE_DESC(k[B + i], k[B + j]); } else { CE_DESC(k[B + j], k[B + i]); } } }
}
template <int N, int A, int Bq> __device__ __forceinline__ void merge16_desc(int (&k)[N]) {
#pragma unroll
    for (int i = 0; i < 16; ++i) k[A + i] = max(k[A + i], k[Bq + 15 - i]);
#pragma unroll
    for (int stride = 8; stride > 0; stride >>= 1)
#pragma unroll
        for (int i = 0; i < 16; ++i) { const int j = i ^ stride; if (j > i) { CE_DESC(k[A + i], k[A + j]); } }
}
template <int NA_, int A, int NB_, int Bq> __device__ __forceinline__ void merge16_desc2(int (&ka)[NA_], const int (&kb)[NB_]) {
#pragma unroll
    for (int i = 0; i < 16; ++i) ka[A + i] = max(ka[A + i], kb[Bq + 15 - i]);
#pragma unroll
    for (int stride = 8; stride > 0; stride >>= 1)
#pragma unroll
        for (int i = 0; i < 16; ++i) { const int j = i ^ stride; if (j > i) { CE_DESC(ka[A + i], ka[A + j]); } }
}
struct PairTab { int i[64], j[64], n; };
constexpr PairTab make_pairs() { PairTab t{}; int n = 0; for (int i = 0; i < 16; ++i) for (int j = 0; j < 16; ++j) if ((i + 1) * (j + 1) <= 16) { t.i[n] = i; t.j[n] = j; ++n; } t.n = n; return t; }

__device__ __forceinline__ void peer_topk_phase(const Ctx& C, const Params& P, int layer) {
    const bf16_t* pq = (const bf16_t*)(P.ws + WS_PQ); const bf16_t* keys = (const bf16_t*)(P.ws + WS_KEYS) + (size_t)layer * 8 * 2 * 128 * 128;
    int* seli = (int*)(P.ws + WS_SELI); float* selg = (float*)(P.ws + WS_SELG);
    const int lane = C.lane, r32 = lane & 31, hh = lane >> 5;
    const int nw = C.G * 8;
    for (int item = C.bid * 8 + C.wave; item < 256 * 8; item += nw) {
        const int tt = item >> 3, h = item & 7;
        int k[16];
        {
            const bf16_t* qp = pq + (size_t)(32 * tt + r32) * D + h * 256 + 8 * hh;
            const bf16_t* kp = keys + ((size_t)(h * 2) * 128 + r32) * 128 + 8 * hh;
#pragma unroll
            for (int nt = 0; nt < 4; ++nt) {
                f32x16 X0, X1;
#pragma unroll
                for (int i = 0; i < 16; ++i) { X0[i] = 0.f; X1[i] = 0.f; }
#pragma unroll
                for (int s = 0; s < 8; ++s) { const bf16x8 a = *(const bf16x8*)(kp + (size_t)nt * 32 * 128 + 16 * s); const bf16x8 q = *(const bf16x8*)(qp + 16 * s);
                    X0 = __builtin_amdgcn_mfma_f32_32x32x16_bf16(a, q, X0, 0, 0, 0); }
#pragma unroll
                for (int s = 0; s < 8; ++s) { const bf16x8 a = *(const bf16x8*)(kp + (size_t)(128 + nt * 32) * 128 + 16 * s); const bf16x8 q = *(const bf16x8*)(qp + 128 + 16 * s);
                    X1 = __builtin_amdgcn_mfma_f32_32x32x16_bf16(a, q, X1, 0, 0, 0); }
                int k32[32];
#pragma unroll
                for (int c = 0; c < 16; ++c) {
                    auto t2 = __builtin_amdgcn_permlane32_swap(__float_as_uint(X0[c]), __float_as_uint(X1[c]), false, false);
                    const int key0 = 32 * nt + (c & 3) + 8 * (c >> 2);
                    k32[2 * c] = okey(__uint_as_float(t2[0]), (unsigned)key0, 127u);
                    k32[2 * c + 1] = okey(__uint_as_float(t2[1]), (unsigned)(key0 + 4), 127u); }
                sort16_desc<32, 0>(k32); sort16_desc<32, 16>(k32); merge16_desc<32, 0, 16>(k32);
                if (nt == 0) {
#pragma unroll
                    for (int i = 0; i < 16; ++i) k[i] = k32[i];
                } else merge16_desc2<16, 0, 32, 0>(k, k32);
                __builtin_amdgcn_sched_barrier(0);
            }
        }
        float av[16], bv[16]; unsigned apk[4] = {0u, 0u, 0u, 0u}, bpk[4] = {0u, 0u, 0u, 0u};
#pragma unroll
        for (int i = 0; i < 16; ++i) {
            const unsigned bits = okey_bits(k[i]);
            auto t2 = __builtin_amdgcn_permlane32_swap(bits, bits, false, false);
            const unsigned ab = t2[0], bb = t2[1];
            av[i] = __uint_as_float(ab & ~127u); bv[i] = __uint_as_float(bb & ~127u);
            apk[i >> 2] |= (ab & 127u) << (8 * (i & 3)); bpk[i >> 2] |= (bb & 127u) << (8 * (i & 3)); }
        constexpr PairTab PT = make_pairs();
        int k2[64];
#pragma unroll
        for (int s = 0; s < 64; ++s) k2[s] = (s < PT.n) ? okey(av[PT.i[s < PT.n ? s : 0]] + bv[PT.j[s < PT.n ? s : 0]], (unsigned)(PT.i[s < PT.n ? s : 0] * 16 + PT.j[s < PT.n ? s : 0]), 255u) : (int)0x80000000;
        sort16_desc<64, 0>(k2); sort16_desc<64, 16>(k2); sort16_desc<64, 32>(k2); sort16_desc<64, 48>(k2);
        merge16_desc<64, 0, 16>(k2); merge16_desc<64, 32, 48>(k2); merge16_desc<64, 0, 32>(k2);
        float bs[16]; int eid[16];
#pragma unroll
        for (int w = 0; w < 16; ++w) { const unsigned bits = okey_bits(k2[w]); const unsigned code = bits & 255u, ci = code >> 4, cj = code & 15u;
            bs[w] = __uint_as_float(bits & ~255u);
            const unsigned aw = (ci >> 2) == 0 ? apk[0] : (ci >> 2) == 1 ? apk[1] : (ci >> 2) == 2 ? apk[2] : apk[3];
            const unsigned bw = (cj >> 2) == 0 ? bpk[0] : (cj >> 2) == 1 ? bpk[1] : (cj >> 2) == 2 ? bpk[2] : bpk[3];
            eid[w] = (int)(((aw >> (8 * (ci & 3))) & 127u) * 128u + ((bw >> (8 * (cj & 3))) & 127u)); }
        float sum = 0.f; const float bmax = bs[0];
#pragma unroll
        for (int w = 0; w < 16; ++w) { bs[w] = __expf(bs[w] - bmax); sum += bs[w]; }
        const float inv = 1.f / sum;
        if (hh == 0) {
            int* ip = seli + (size_t)(32 * tt + r32) * 128 + h * 16; float* gp = selg + (size_t)(32 * tt + r32) * 128 + h * 16;
#pragma unroll
            for (int w = 0; w < 16; w += 4) { *(int4*)(ip + w) = make_int4(eid[w], eid[w + 1], eid[w + 2], eid[w + 3]);
                *(f32x4*)(gp + w) = (f32x4){bs[w] * inv, bs[w + 1] * inv, bs[w + 2] * inv, bs[w + 3] * inv}; }
        }
    }
}

__device__ __forceinline__ float rl_f(float x, int l) { return __int_as_float(__builtin_amdgcn_readlane(__float_as_int(x), l)); }
__device__ __forceinline__ float gelu_exact(float v) { return 0.5f * v * (1.f + erff(v * 0.70710678118654752f)); }
__device__ __forceinline__ void peer_gather_phase(const Ctx& C, const Params& P, int layer, const float* hin, float* hout, const float* gate2) {
    const bf16_t* xf = (const bf16_t*)(P.ws + WS_XM);
    const bf16_t* U = (const bf16_t*)(P.ws + WS_U) + (size_t)layer * NE * D; const bf16_t* V = (const bf16_t*)(P.ws + WS_V) + (size_t)layer * NE * D;
    const int* seli = (const int*)(P.ws + WS_SELI); const float* selg = (const float*)(P.ws + WS_SELG);
    const int lane = C.lane, nw = C.G * 8;
    for (int t = C.bid * 8 + C.wave; t < T; t += nw) {
        float xv[32];
#pragma unroll
        for (int c = 0; c < 4; ++c) { const u32x4 r = *(const u32x4*)(xf + (size_t)t * D + 512 * c + 8 * lane);
#pragma unroll
            for (int j = 0; j < 4; ++j) { xv[8 * c + 2 * j] = bf_lo(r[j]); xv[8 * c + 2 * j + 1] = bf_hi(r[j]); } }
        const int e_lo = seli[(size_t)t * 128 + lane], e_hi = seli[(size_t)t * 128 + 64 + lane];
        const float g_lo = selg[(size_t)t * 128 + lane], g_hi = selg[(size_t)t * 128 + 64 + lane];
        float w_lo = 0.f, w_hi = 0.f;
#pragma unroll 1
        for (int k0 = 0; k0 < 128; k0 += 8) {
            u32x4 ur[8][4];
#pragma unroll
            for (int q = 0; q < 8; ++q) { const int k = k0 + q; const int e = (k < 64) ? __builtin_amdgcn_readlane(e_lo, k & 63) : __builtin_amdgcn_readlane(e_hi, k & 63);
                const bf16_t* up = U + (size_t)e * D + 8 * lane;
#pragma unroll
                for (int c = 0; c < 4; ++c) ur[q][c] = *(const u32x4*)(up + 512 * c); }
#pragma unroll
            for (int q = 0; q < 8; ++q) { float d = 0.f;
#pragma unroll
                for (int c = 0; c < 4; ++c)
#pragma unroll
                    for (int j = 0; j < 4; ++j) { d += bf_lo(ur[q][c][j]) * xv[8 * c + 2 * j]; d += bf_hi(ur[q][c][j]) * xv[8 * c + 2 * j + 1]; }
                d = wave_sum(d);
                const int k = k0 + q; const float gk = (k < 64) ? rl_f(g_lo, k & 63) : rl_f(g_hi, k & 63);
                const float w = gelu_exact(d) * gk;
                if (k < 64) { w_lo = (lane == (k & 63)) ? w : w_lo; } else { w_hi = (lane == (k & 63)) ? w : w_hi; } }
        }
        float acc[32];
#pragma unroll
        for (int i = 0; i < 32; ++i) acc[i] = 0.f;
#pragma unroll 1
        for (int k0 = 0; k0 < 128; k0 += 8) {
            u32x4 vr[8][4];
#pragma unroll
            for (int q = 0; q < 8; ++q) { const int k = k0 + q; const int e = (k < 64) ? __builtin_amdgcn_readlane(e_lo, k & 63) : __builtin_amdgcn_readlane(e_hi, k & 63);
                const bf16_t* vp = V + (size_t)e * D + 8 * lane;
#pragma unroll
                for (int c = 0; c < 4; ++c) vr[q][c] = *(const u32x4*)(vp + 512 * c); }
#pragma unroll
            for (int q = 0; q < 8; ++q) { const int k = k0 + q; const float w = (k < 64) ? rl_f(w_lo, k & 63) : rl_f(w_hi, k & 63);
#pragma unroll
                for (int c = 0; c < 4; ++c)
#pragma unroll
                    for (int j = 0; j < 4; ++j) { acc[8 * c + 2 * j] += w * bf_lo(vr[q][c][j]); acc[8 * c + 2 * j + 1] += w * bf_hi(vr[q][c][j]); } }
        }
        const int b = t >> 12;
#pragma unroll
        for (int c = 0; c < 4; ++c) { const size_t off = (size_t)t * D + 512 * c + 8 * lane; const float* gp = gate2 + (size_t)b * MOD6 + 512 * c + 8 * lane;
#pragma unroll
            for (int q = 0; q < 2; ++q) { const f32x4 hv = *(const f32x4*)(hin + off + 4 * q), gv = *(const f32x4*)(gp + 4 * q);
                f32x4 o; o[0] = hv[0] + gv[0] * acc[8 * c + 4 * q]; o[1] = hv[1] + gv[1] * acc[8 * c + 4 * q + 1]; o[2] = hv[2] + gv[2] * acc[8 * c + 4 * q + 2]; o[3] = hv[3] + gv[3] * acc[8 * c + 4 * q + 3];
                *(f32x4*)(hout + off + 4 * q) = o; } }
    }
}
__global__ void __launch_bounds__(512, 2) hybrid_fwd(Params P) {
    extern __shared__ __attribute__((aligned(16))) unsigned char lds_raw[];
    Ctx C; C.lds = (LAS unsigned char*)lds_raw; C.tid = threadIdx.x; C.lane = C.tid & 63; C.wave = __builtin_amdgcn_readfirstlane(C.tid >> 6); C.G = gridDim.x; C.bid = blockIdx.x;
    volatile LAS unsigned* xbw = (volatile LAS unsigned*)(C.lds + LDS_BYTES - 16);
    if (C.tid == 0) { xbw[0] = 0u; xbw[1] = 0u; xbw[2] = 0u; xbw[3] = 0u; }
    __syncthreads();
    const int lo = P.ph_lo, hi = P.ph_hi;
    const bool multi = (hi - lo) > 1;
    XcdBarrier bar; bar.bar = (unsigned*)(P.ws + WS_BAR); bar.x = 0; bar.st = xbw;
    if (multi) bar = xcd_barrier_post((unsigned*)(P.ws + WS_BAR), xbw);
#ifndef PH_MASK
#define PH_MASK 0x3ffff
#endif
#define IN(k) (lo <= (k) && (k) < hi && ((PH_MASK >> (k)) & 1))
#define SEAM(k) do { if (IN(k) && IN((k) + 1)) xcd_barrier(bar); } while (0)
    unsigned char* ws = P.ws;
    float* mod = (float*)(ws + WS_MOD);
    bf16_t* XM = (bf16_t*)(ws + WS_XM); float* H1 = (float*)(ws + WS_H1); float* H2 = (float*)(ws + WS_H2);
    bf16_t* QKV = (bf16_t*)(ws + WS_QKV); bf16_t* Y = (bf16_t*)(ws + WS_Y); bf16_t* PQ = (bf16_t*)(ws + WS_PQ);
    const bf16_t* WinA = (const bf16_t*)(ws + WS_WINA); const bf16_t* WinB = (const bf16_t*)(ws + WS_WINB);
    const bf16_t* Wout = (const bf16_t*)(ws + WS_WOUT); const bf16_t* Wq = (const bf16_t*)(ws + WS_WQ);

    if (IN(0)) p0_prologue(C, P);
    SEAM(0);
    if (IN(1)) norm_mod_phase(C, P.x, P.norm1_g, mod + 0 * D, mod + 1 * D, XM);
    SEAM(1);
    if (IN(2)) { pg8::Gemm g{XM, WinA, T, NA, D}; pg8::StaticOrder S; S.init(T, NA, C.G, C.bid); pg8::EpiStoreBf16 E{QKV, NA}; pg8::gemm_phase(C.lds, g, S, E); }
    SEAM(2);
    if (IN(3)) attn_dilated_phase(C, P);
    SEAM(3);
    if (IN(4)) combine_phase(C, P);
    SEAM(4);
    if (IN(5)) { pg8::Gemm g{Y, Wout, T, D, D}; pg8::StaticOrder S; S.init(T, D, C.G, C.bid); pg8::EpiResGate E{P.x, H1, mod + 2 * D}; pg8::gemm_phase(C.lds, g, S, E); }
    SEAM(5);
    if (IN(6)) norm_mod_phase(C, H1, P.norm2_g, mod + 3 * D, mod + 4 * D, XM);
    SEAM(6);
    if (IN(7)) { pg8::Gemm g{XM, Wq, T, D, D}; pg8::StaticOrder S; S.init(T, D, C.G, C.bid); pg8::EpiStoreBf16 E{PQ, D}; pg8::gemm_phase(C.lds, g, S, E); }
    SEAM(7);
    if (IN(8)) peer_topk_phase(C, P, 0);
    SEAM(8);
    if (IN(9)) peer_gather_phase(C, P, 0, H1, H2, mod + 5 * D);
    SEAM(9);
    float* mod1 = mod + 2 * MOD6;
    if (IN(10)) norm_mod_phase(C, H2, P.norm1_g + D, mod1 + 0 * D, mod1 + 1 * D, XM);
    SEAM(10);
    if (IN(11)) { pg8::Gemm g{XM, WinB, T, NBP, D}; pg8::StaticOrder S; S.init(T, NBP, C.G, C.bid); pg8::EpiStoreBf16 E{QKV, NBP}; pg8::gemm_phase(C.lds, g, S, E); }
    SEAM(11);
    if (IN(12)) attn_stick_phase(C, P);
    SEAM(12);
    if (IN(13)) { pg8::Gemm g{Y, Wout + (size_t)D * D, T, D, D}; pg8::StaticOrder S; S.init(T, D, C.G, C.bid); pg8::EpiResGate E{H2, H1, mod1 + 2 * D}; pg8::gemm_phase(C.lds, g, S, E); }
    SEAM(13);
    if (IN(14)) norm_mod_phase(C, H1, P.norm2_g + D, mod1 + 3 * D, mod1 + 4 * D, XM);
    SEAM(14);
    if (IN(15)) { pg8::Gemm g{XM, Wq + (size_t)D * D, T, D, D}; pg8::StaticOrder S; S.init(T, D, C.G, C.bid); pg8::EpiStoreBf16 E{PQ, D}; pg8::gemm_phase(C.lds, g, S, E); }
    SEAM(15);
    if (IN(16)) peer_topk_phase(C, P, 1);
    SEAM(16);
    if (IN(17)) peer_gather_phase(C, P, 1, H1, P.out, mod1 + 5 * D);
#undef IN
#undef SEAM
}

#ifndef N_LAUNCH_MODE
#define N_LAUNCH_MODE 1
#endif
constexpr int N_PHASES = 18;
extern "C" void kernel_launch(void* const* d_in, const int* in_sizes, int n_in, void* d_out, int out_size, void* d_ws, size_t ws_size, hipStream_t stream) {
    static int grid = 0;
    if (grid == 0) {
        if (n_in != 16 || out_size != T * D || ws_size < WS_END) { fprintf(stderr, "kernel_launch: unexpected sizes (n_in %d out %d ws %zu need %zu)\n", n_in, out_size, ws_size, (size_t)WS_END); grid = -1; return; }
        int dev = 0, cus = 0, per_cu = 0;
        if (hipGetDevice(&dev) != hipSuccess || hipDeviceGetAttribute(&cus, hipDeviceAttributeMultiprocessorCount, dev) != hipSuccess) { grid = -1; return; }
        if (hipFuncSetAttribute((const void*)hybrid_fwd, hipFuncAttributeMaxDynamicSharedMemorySize, LDS_BYTES) != hipSuccess) { fprintf(stderr, "kernel_launch: hipFuncSetAttribute failed\n"); grid = -1; return; }
        if (hipOccupancyMaxActiveBlocksPerMultiprocessor(&per_cu, (const void*)hybrid_fwd, 512, LDS_BYTES) != hipSuccess || per_cu < 1) { fprintf(stderr, "kernel_launch: occupancy query says %d\n", per_cu); }
        (void)hipGetLastError();
        grid = cus;
    }
    if (grid < 0) return;
    (void)hipMemsetAsync((char*)d_ws + WS_BAR, 0, 16384, stream);
    Params p{};
    p.x = (const float*)d_in[0]; p.c = (const float*)d_in[1]; p.rel_bias = (const float*)d_in[2]; p.norm1_g = (const float*)d_in[3]; p.norm2_g = (const float*)d_in[4];
    p.w_ada = (const float*)d_in[5]; p.b_ada = (const float*)d_in[6]; p.a_w_in = (const float*)d_in[7]; p.a_q_gain = (const float*)d_in[8]; p.a_k_gain = (const float*)d_in[9];
    p.b_w_in = (const float*)d_in[10]; p.w_out = (const float*)d_in[11]; p.peer_wq = (const float*)d_in[12]; p.peer_keys = (const float*)d_in[13]; p.peer_u = (const float*)d_in[14]; p.peer_v = (const float*)d_in[15];
    p.out = (float*)d_out; p.ws = (unsigned char*)d_ws;
    if (N_LAUNCH_MODE == 1) { p.ph_lo = 0; p.ph_hi = N_PHASES; hipLaunchKernelGGL(hybrid_fwd, dim3(grid), dim3(512), LDS_BYTES, stream, p); }
    else for (int k = 0; k < N_PHASES; ++k) { p.ph_lo = k; p.ph_hi = k + 1; hipLaunchKernelGGL(hybrid_fwd, dim3(grid), dim3(512), LDS_BYTES, stream, p); }
}
```

```cpp
#include <hip/hip_runtime.h>
#include <stdint.h>
#include <stdio.h>

#define LAS __attribute__((address_space(3)))
typedef unsigned short bf16_t;
typedef short bf16x8 __attribute__((ext_vector_type(8)));
typedef short s16x4 __attribute__((ext_vector_type(4)));
typedef float f32x2 __attribute__((ext_vector_type(2)));
typedef float f32x4 __attribute__((ext_vector_type(4)));
typedef float f32x16 __attribute__((ext_vector_type(16)));
typedef unsigned u32x4 __attribute__((ext_vector_type(4)));
typedef unsigned u32x2 __attribute__((ext_vector_type(2)));

constexpr int D = 2048, NBATCH = 2, SEQ = 4096, T = NBATCH * SEQ;
constexpr int NA = 18432, NBP = 6144, NE = 16384, MOD6 = 6 * D;
constexpr float EPS = 1e-6f;
constexpr float U_SCALE = 512.f, V_SCALE = 32.f;

constexpr size_t MB = 1024 * 1024;
constexpr size_t WS_BAR = 0;
constexpr size_t WS_MOD = 16384;
constexpr size_t WS_BIASD = WS_MOD + 2 * 2 * MOD6 * 4;
constexpr size_t WS_WINA = 1 * MB;
constexpr size_t WS_WINB = WS_WINA + (size_t)NA * D * 2;
constexpr size_t WS_WOUT = WS_WINB + (size_t)NBP * D * 2;
constexpr size_t WS_WQ = WS_WOUT + (size_t)2 * D * D * 2;
constexpr size_t WS_KEYS = WS_WQ + (size_t)2 * D * D * 2;
constexpr size_t WS_U = WS_KEYS + (size_t)2 * 8 * 2 * 128 * 128 * 2;
constexpr size_t WS_V = WS_U + (size_t)2 * NE * D;
constexpr size_t WS_XM = WS_V + (size_t)2 * NE * D;
constexpr size_t WS_H1 = WS_XM + (size_t)T * D * 2;
constexpr size_t WS_H2 = WS_H1 + (size_t)T * D * 4;
constexpr size_t WS_OG = WS_H2 + (size_t)T * D * 4;
constexpr size_t WS_LSE = WS_OG + (size_t)3 * T * D * 2;
constexpr size_t WS_QKV = WS_LSE + (size_t)3 * T * 16 * 4;
constexpr size_t WS_Y = WS_QKV + 112 * MB;
constexpr size_t WS_PQ = WS_Y + (size_t)T * D * 2;
constexpr size_t WS_SELI = WS_PQ + (size_t)T * D * 2;
constexpr size_t WS_SELG = WS_SELI + (size_t)T * 128 * 4;
constexpr size_t WS_END = WS_QKV + (size_t)T * NA * 2;
static_assert(WS_SELG + (size_t)T * 128 * 4 <= WS_END, "aliases must fit inside the qkv region");
static_assert(WS_QKV + (size_t)T * NBP * 2 <= WS_Y, "layer-1 qkv must not overlap y");

constexpr int LDS_BYTES = 159 * 1024;

__device__ __forceinline__ unsigned cvt_pk_bf16(float lo, float hi) { unsigned r; asm volatile("v_cvt_pk_bf16_f32 %0, %1, %2" : "=v"(r) : "v"(lo), "v"(hi)); return r; }
__device__ __forceinline__ float bf_lo(unsigned u) { return __uint_as_float(u << 16); }
__device__ __forceinline__ float bf_hi(unsigned u) { return __uint_as_float(u & 0xffff0000u); }
__device__ __forceinline__ bf16_t f2bf(float f) { unsigned u = __float_as_uint(f); u += 0x7FFFu + ((u >> 16) & 1u); return (bf16_t)(u >> 16); }
template <int CTRL> __device__ __forceinline__ float dppf(float x) { return __builtin_bit_cast(float, __builtin_amdgcn_mov_dpp(__builtin_bit_cast(int, x), CTRL, 0xf, 0xf, true)); }
__device__ __forceinline__ float row16_sum(float x) { x += dppf<0xB1>(x); x += dppf<0x4E>(x); x += dppf<0x141>(x); x += dppf<0x140>(x); return x; }
__device__ __forceinline__ float half_swap_sum(float x) { auto t = __builtin_amdgcn_permlane32_swap(__float_as_uint(x), __float_as_uint(x), false, false); return __uint_as_float(t[0]) + __uint_as_float(t[1]); }
__device__ __forceinline__ float half_swap_max(float x) { auto t = __builtin_amdgcn_permlane32_swap(__float_as_uint(x), __float_as_uint(x), false, false); return fmaxf(__uint_as_float(t[0]), __uint_as_float(t[1])); }
__device__ __forceinline__ float wave_sum(float x) { x = row16_sum(x); x += __shfl_xor(x, 16); x = half_swap_sum(x); return x; }
#define XB_TMO      128
#define XB_XCNT(j)  (256  + 64 * (j))
#define XB_XSUB(j)  (1280 + 64 * (j))
#define XB_XGEN(j)  (2304 + 64 * (j))
#define XB_TOP      3328
#define XB_TOPGEN   3392
#define XCD_BAR_WORDS 3456
#define XB_SPIN_CAP (1u << 18)

__device__ __forceinline__ unsigned xb_ld(unsigned* p)              { return __hip_atomic_load(p, __ATOMIC_RELAXED, __HIP_MEMORY_SCOPE_AGENT); }
__device__ __forceinline__ unsigned xb_add(unsigned* p, unsigned v) { return __hip_atomic_fetch_add(p, v, __ATOMIC_RELAXED, __HIP_MEMORY_SCOPE_AGENT); }
__device__ __forceinline__ unsigned xb_xcc_id() { return (unsigned)__builtin_amdgcn_s_getreg((3 << 11) | 20) & 0xFu; }
#define XB_SPIN(cond, bar) do { unsigned _sp = 0; while (cond) { __builtin_amdgcn_s_sleep(1); \
    if ((++_sp & 255u) == 0u) { if (xb_ld(&(bar)[XB_TMO])) break; if (_sp > XB_SPIN_CAP) { atomicAdd(&(bar)[XB_TMO], 1u); break; } } } } while (0)

struct XcdBarrier {
    unsigned* bar; unsigned x;
    volatile LAS unsigned* st;
};

__device__ __forceinline__ XcdBarrier xcd_barrier_post(unsigned* bar, volatile LAS unsigned* st) {
    XcdBarrier b; b.bar = bar; b.x = xb_xcc_id(); b.st = st;
    if (threadIdx.x == 0) (void)xb_add(&bar[XB_XCNT(b.x)], 1u);
    return b;
}
__device__ __forceinline__ void xcd_barrier_complete(unsigned* bar, unsigned x, unsigned& nloc, unsigned& nx) {
    const unsigned G = gridDim.x * gridDim.y * gridDim.z;
    unsigned sum, cnt, mine, sp = 0u;
    for (;;) {
        sum = 0u; cnt = 0u; mine = 0u;
#pragma unroll
        for (unsigned j = 0; j < 16; ++j) { const unsigned c = xb_ld(&bar[XB_XCNT(j)]); sum += c; cnt += (c > 0u) ? 1u : 0u; mine = (j == x) ? c : mine; }
        if (sum == G) break;
        __builtin_amdgcn_s_sleep(1);
        if ((++sp & 255u) == 0u) { if (xb_ld(&bar[XB_TMO])) break; if (sp > XB_SPIN_CAP) { atomicAdd(&bar[XB_TMO], 1u); break; } }
    }
    nloc = mine > 0u ? mine : 1u; nx = cnt > 0u ? cnt : 1u;
}

__device__ __forceinline__ void xcd_barrier(const XcdBarrier& b) {
    asm volatile("s_waitcnt vmcnt(0)" ::: "memory");
    __syncthreads();
    if (threadIdx.x == 0) {
        unsigned* bar = b.bar;
        __builtin_amdgcn_s_waitcnt(0);
        unsigned nloc = b.st[0], nx = b.st[1];
        if (nloc == 0u) { xcd_barrier_complete(bar, b.x, nloc, nx); b.st[0] = nloc; b.st[1] = nx; }
        const unsigned old = xb_add(&bar[XB_XSUB(b.x)], 1u);
        const unsigned gen = old / nloc;
        if (old + 1u == (gen + 1u) * nloc) {
            __builtin_amdgcn_fence(__ATOMIC_RELEASE, "agent");
            asm volatile("s_waitcnt vmcnt(0)" ::: "memory");
            const unsigned og = xb_add(&bar[XB_TOP], 1u);
            const unsigned tg = og / nx;
            if (og + 1u == (tg + 1u) * nx) xb_add(&bar[XB_TOPGEN], 1u);
            else XB_SPIN(xb_ld(&bar[XB_TOPGEN]) == tg, bar);
            __builtin_amdgcn_fence(__ATOMIC_ACQUIRE, "agent");
            xb_add(&bar[XB_XGEN(b.x)], 1u);
            asm volatile("s_waitcnt vmcnt(0)" ::: "memory");
        } else {
            XB_SPIN(xb_ld(&bar[XB_XGEN(b.x)]) == gen, bar);
            __builtin_amdgcn_fence(__ATOMIC_ACQUIRE, "agent");
            asm volatile("s_waitcnt vmcnt(0)" ::: "memory");
        }
    }
    __syncthreads();
}
namespace pg8 {
#define PG8_LAS __attribute__((address_space(3)))
constexpr int BM = 256, BK = 64, HALF = 128, HTB = HALF * BK * 2  , STAGE_BYTES = 8 * HTB, NXCD = 8, WGM = 8;

__host__ __device__ __forceinline__ int lds_byte(int r, int c) { const int st = (r >> 4) * 2 + (c >> 5), rr = r & 15, cc = c & 31, ob = rr * 64 + cc * 2; return st * 1024 + (ob ^ (((ob >> 9) & 1) << 5)); }
__host__ __device__ __forceinline__ void stage_rc(int b, int& R, int& C) { const int st = b / 1024, sb = b % 1024, swz = sb ^ (((sb >> 9) & 1) << 5); R = (st >> 1) * 16 + swz / 64; C = (st & 1) * 32 + (swz % 64) / 2; }
__host__ __device__ __forceinline__ int perm32(int rho) { const int n = rho >> 4, i = rho & 15; return 8 * (i >> 2) + 4 * n + (i & 3); }

struct Unit { int pm, pn; };
struct Gemm { const bf16_t* A; const bf16_t* Bt; int M, N, K; };

struct StaticOrder {
    int nM, nN, nwg, G, c;
    __host__ __device__ void init(int M, int N, int G_, int c_) { nM = M / BM; nN = N / BM; nwg = nM * nN; G = G_; c = c_; }
    __host__ __device__ bool next(int i, Unit& u) const {
        const long L = (long)i * G + c; if (L >= nwg) return false;
        int wgid = (int)L; { const int q = nwg / NXCD, r = nwg % NXCD, xcd = wgid % NXCD, off = wgid / NXCD; wgid = (xcd < r ? xcd * (q + 1) : r * (q + 1) + (xcd - r) * q) + off; }
        const int nig = WGM * nN, gid = wgid / nig, fm = gid * WGM, gsz = (nM - fm) < WGM ? (nM - fm) : WGM;
        u.pm = fm + ((wgid % nig) % gsz); u.pn = (wgid % nig) / gsz; return true;
    }
    __device__ __forceinline__ void a_ready(const Unit&) const {}
    __device__ __forceinline__ void done(const Unit&) const {}
};

template <class Epi, class Sched>
__device__ __forceinline__ void gemm_phase(PG8_LAS unsigned char* lds, const Gemm g, const Sched& S, const Epi& E) {
    const int tid = threadIdx.x, wid = __builtin_amdgcn_readfirstlane(tid >> 6), lane = tid & 63, wr = wid >> 2, wc = wid & 3, fr = lane & 15, fq = lane >> 4;
    const int K = g.K, nt = K / BK;
    unsigned voffA[2], voffB[2];
#pragma unroll
    for (int i = 0; i < 2; ++i) { int R, C; stage_rc(tid * 16 + i * 8192, R, C); const int Rb = Epi::PERM ? ((R & ~31) + perm32(R & 31)) : R;
        voffA[i] = (unsigned)(R * K + C) * 2u; voffB[i] = (unsigned)(Rb * K + C) * 2u; }
    const size_t kstep = (size_t)(BK * 2);
    const size_t hstep = (size_t)HALF * K * 2;
    const size_t tstep = 2 * hstep;
    const unsigned ldsw = (unsigned)wid * 1024u;
    const int aoff = lds_byte(wr * 64 + fr, fq * 8), boff = lds_byte(wc * 32 + fr, fq * 8);
#define PG8_SA(b, h) (((b) * 2 + (h)) * HTB)
#define PG8_SB(b, h) ((4 + (b) * 2 + (h)) * HTB)
#define PG8_STAGE(bufoff, gbase, voff) do { _Pragma("unroll") for (int _i = 0; _i < 2; ++_i) \
        __builtin_amdgcn_global_load_lds((const unsigned*)((const char*)(gbase) + (voff)[_i]), (PG8_LAS unsigned*)(lds + (bufoff) + ldsw + _i * 8192), 16, 0, 0); } while (0)
#define PG8_LDA(dst, b, h) do { _Pragma("unroll") for (int m = 0; m < 4; ++m) _Pragma("unroll") for (int k = 0; k < 2; ++k) dst[m][k] = *(const PG8_LAS bf16x8*)(lds + PG8_SA(b, h) + aoff + m * 2048 + k * 1024); } while (0)
#define PG8_LDB(dst, b, h) do { _Pragma("unroll") for (int n = 0; n < 2; ++n) _Pragma("unroll") for (int k = 0; k < 2; ++k) dst[n][k] = *(const PG8_LAS bf16x8*)(lds + PG8_SB(b, h) + boff + n * 2048 + k * 1024); } while (0)
#define PG8_MMA(ai, bj, At, Bt) do { __builtin_amdgcn_s_setprio(1); _Pragma("unroll") for (int m = 0; m < 4; ++m) _Pragma("unroll") for (int n = 0; n < 2; ++n) _Pragma("unroll") for (int k = 0; k < 2; ++k) \
        acc[ai][bj][m][n] = __builtin_amdgcn_mfma_f32_16x16x32_bf16(Bt[n][k], At[m][k], acc[ai][bj][m][n], 0, 0, 0); __builtin_amdgcn_s_setprio(0); } while (0)
#define PG8_WAIT_V(n) asm volatile("s_waitcnt vmcnt(" #n ")" ::: "memory")
#define PG8_WAIT_L(n) asm volatile("s_waitcnt lgkmcnt(" #n ")" ::: "memory")
#define PG8_BAR __builtin_amdgcn_s_barrier()
#define PG8_SCHED __builtin_amdgcn_sched_barrier(0)
    Unit cur, nxt; int ui = 0;
    if (!S.next(0, cur)) return;
    f32x4 acc[2][2][4][2];
#pragma unroll
    for (int a = 0; a < 2; ++a)
#pragma unroll
        for (int b = 0; b < 2; ++b)
#pragma unroll
            for (int m = 0; m < 4; ++m)
#pragma unroll
                for (int n = 0; n < 2; ++n) acc[a][b][m][n] = (f32x4){0.f, 0.f, 0.f, 0.f};
    bf16x8 At[4][2], B0[2][2], B1[2][2];
    const char* cA = (const char*)g.A + (size_t)cur.pm * tstep; const char* cB = (const char*)g.Bt + (size_t)cur.pn * tstep;
    S.a_ready(cur);
    PG8_STAGE(PG8_SB(0, 0), cB, voffB); PG8_STAGE(PG8_SA(0, 0), cA, voffA); PG8_STAGE(PG8_SB(0, 1), cB + hstep, voffB); PG8_STAGE(PG8_SA(0, 1), cA + hstep, voffA);
    if (wr == 1) PG8_BAR;
    PG8_WAIT_V(4); PG8_BAR;
    PG8_STAGE(PG8_SB(1, 0), cB + kstep, voffB); PG8_STAGE(PG8_SA(1, 0), cA + kstep, voffA); PG8_STAGE(PG8_SB(1, 1), cB + hstep + kstep, voffB);
    PG8_WAIT_V(6); PG8_BAR;
    for (;;) {
        const bool has_next = S.next(ui + 1, nxt);
        const char* nA = has_next ? (const char*)g.A + (size_t)nxt.pm * tstep : cA; const char* nB = has_next ? (const char*)g.Bt + (size_t)nxt.pn * tstep : cB;
        for (int t = 0; t < nt; t += 2) {
            const bool last = (t == nt - 2);
            const char* a1 = cA + (size_t)(t + 1) * kstep;
            const char* a2 = last ? nA : cA + (size_t)(t + 2) * kstep; const char* b2 = last ? nB : cB + (size_t)(t + 2) * kstep;
            const char* a3 = a2 + kstep; const char* b3 = b2 + kstep;
            if (last && has_next) S.a_ready(nxt);
            PG8_LDB(B0, 0, 0); PG8_SCHED; PG8_LDA(At, 0, 0); PG8_STAGE(PG8_SA(1, 1), a1 + hstep, voffA);
            PG8_WAIT_L(8); PG8_BAR; PG8_WAIT_L(0); PG8_MMA(0, 0, At, B0); PG8_BAR; PG8_SCHED;
            PG8_LDB(B1, 0, 1); PG8_STAGE(PG8_SB(0, 0), b2, voffB);
            PG8_BAR; PG8_WAIT_L(0); PG8_MMA(0, 1, At, B1); PG8_BAR;
            PG8_LDA(At, 0, 1); PG8_STAGE(PG8_SA(0, 0), a2, voffA);
            PG8_BAR; PG8_WAIT_L(0); PG8_MMA(1, 0, At, B0); PG8_BAR; PG8_SCHED;
            PG8_STAGE(PG8_SB(0, 1), b2 + hstep, voffB);
            PG8_WAIT_V(6); PG8_BAR; PG8_MMA(1, 1, At, B1); PG8_BAR;
            PG8_LDB(B0, 1, 0); PG8_SCHED; PG8_LDA(At, 1, 0); PG8_STAGE(PG8_SA(0, 1), a2 + hstep, voffA);
            PG8_WAIT_L(8); PG8_BAR; PG8_WAIT_L(0); PG8_MMA(0, 0, At, B0); PG8_BAR; PG8_SCHED;
            PG8_LDB(B1, 1, 1); PG8_STAGE(PG8_SB(1, 0), b3, voffB);
            PG8_BAR; PG8_WAIT_L(0); PG8_MMA(0, 1, At, B1); PG8_BAR;
            PG8_LDA(At, 1, 1); PG8_STAGE(PG8_SA(1, 0), a3, voffA);
            PG8_BAR; PG8_WAIT_L(0); PG8_MMA(1, 0, At, B0); PG8_BAR; PG8_SCHED;
            PG8_STAGE(PG8_SB(1, 1), b3 + hstep, voffB);
            PG8_WAIT_V(6); PG8_BAR; PG8_MMA(1, 1, At, B1); PG8_BAR;
        }
        if constexpr (!Epi::AFTER_DRAIN) { E(acc, cur, wr, wc, fr, fq); S.done(cur); }
        if (!has_next) break;
#pragma unroll
        for (int a = 0; a < 2; ++a)
#pragma unroll
            for (int b = 0; b < 2; ++b)
#pragma unroll
                for (int m = 0; m < 4; ++m)
#pragma unroll
                    for (int n = 0; n < 2; ++n) acc[a][b][m][n] = (f32x4){0.f, 0.f, 0.f, 0.f};
        cur = nxt; cA = nA; cB = nB; ++ui;
    }
    PG8_WAIT_V(0);
    if (wr == 0) PG8_BAR;
    PG8_BAR;
    if constexpr (Epi::AFTER_DRAIN) { E.fused(acc, cur, wr, wc, fr, fq, lds, wid, lane); S.done(cur); }
#undef PG8_SA
#undef PG8_SB
#undef PG8_STAGE
#undef PG8_LDA
#undef PG8_LDB
#undef PG8_MMA
#undef PG8_WAIT_V
#undef PG8_WAIT_L
#undef PG8_BAR
#undef PG8_SCHED
}
}
namespace pg8 {
struct EpiStoreBf16 {
    static constexpr bool PERM = true, AFTER_DRAIN = false;
    bf16_t* O; int ldc;
    __device__ __forceinline__ void operator()(const f32x4 (&acc)[2][2][4][2], const Unit& u, int wr, int wc, int fr, int fq) const {
        const int row0 = u.pm * BM + wr * 64 + fr, col0 = u.pn * BM + wc * 32 + 8 * fq;
#pragma unroll
        for (int ai = 0; ai < 2; ++ai)
#pragma unroll
            for (int m = 0; m < 4; ++m) { bf16_t* rowp = O + (size_t)(row0 + ai * HALF + m * 16) * ldc + col0;
#pragma unroll
                for (int bj = 0; bj < 2; ++bj) { const f32x4 v0 = acc[ai][bj][m][0], v1 = acc[ai][bj][m][1];
                    u32x4 o; o[0] = cvt_pk_bf16(v0[0], v0[1]); o[1] = cvt_pk_bf16(v0[2], v0[3]); o[2] = cvt_pk_bf16(v1[0], v1[1]); o[3] = cvt_pk_bf16(v1[2], v1[3]);
                    *(u32x4*)(rowp + bj * HALF) = o; } }
    }
};
struct EpiResGate {
    static constexpr bool PERM = false, AFTER_DRAIN = false;
    const float* Hin; float* Hout; const float* gate;
    __device__ __forceinline__ void operator()(const f32x4 (&acc)[2][2][4][2], const Unit& u, int wr, int wc, int fr, int fq) const {
        const int row0 = u.pm * BM + wr * 64 + fr, col0 = u.pn * BM + wc * 32 + 4 * fq;
        const float* gp = gate + (size_t)(u.pm >> 4) * MOD6 + col0;
        f32x4 gv[2][2];
#pragma unroll
        for (int bj = 0; bj < 2; ++bj)
#pragma unroll
            for (int n = 0; n < 2; ++n) gv[bj][n] = *(const f32x4*)(gp + bj * HALF + n * 16);
#pragma unroll
        for (int ai = 0; ai < 2; ++ai)
#pragma unroll
            for (int m = 0; m < 4; ++m) { const size_t ro = (size_t)(row0 + ai * HALF + m * 16) * D + col0;
#pragma unroll
                for (int bj = 0; bj < 2; ++bj)
#pragma unroll
                    for (int n = 0; n < 2; ++n) { const f32x4 h = *(const f32x4*)(Hin + ro + bj * HALF + n * 16);
                        *(f32x4*)(Hout + ro + bj * HALF + n * 16) = h + gv[bj][n] * acc[ai][bj][m][n]; } }
    }
};
}

struct Params {
    const float *x, *c, *rel_bias, *norm1_g, *norm2_g, *w_ada, *b_ada, *a_w_in, *a_q_gain, *a_k_gain, *b_w_in, *w_out, *peer_wq, *peer_keys, *peer_u, *peer_v;
    float* out; unsigned char* ws; int ph_lo, ph_hi;
};
struct Ctx { LAS unsigned char* lds; int tid, lane, wave, G, bid; };

__device__ __forceinline__ void p0_transpose(const Ctx& C, const Params& P) {
    bf16_t* WinA = (bf16_t*)(P.ws + WS_WINA); bf16_t* WinB = (bf16_t*)(P.ws + WS_WINB); bf16_t* Wout = (bf16_t*)(P.ws + WS_WOUT); bf16_t* Wq = (bf16_t*)(P.ws + WS_WQ);
    LAS bf16_t* tile = (LAS bf16_t*)C.lds;
    const int kr = C.tid >> 4, cg = C.tid & 15, wn = C.tid >> 3, wk = C.tid & 7;
    for (int ti = C.bid; ti < 16384; ti += C.G) {
        const float* src; bf16_t* dst; int N; int loc = ti;
        if (loc < 9216) { src = P.a_w_in; dst = WinA; N = NA; }
        else if (loc < 9216 + 3072) { loc -= 9216; src = P.b_w_in; dst = WinB; N = NBP; }
        else { loc -= 9216 + 3072; const int m = loc >> 10; loc &= 1023; N = D;
               src = (m < 2) ? P.w_out + (size_t)m * D * D : P.peer_wq + (size_t)(m - 2) * D * D; dst = (m < 2) ? Wout + (size_t)m * D * D : Wq + (size_t)(m - 2) * D * D; }
        const int ntl = N >> 6, kt = loc / ntl, nt = loc - kt * ntl, k0 = kt * 64, n0 = nt * 64;
#pragma unroll
        for (int i = 0; i < 2; ++i) { const f32x4 v = *(const f32x4*)(src + (size_t)(k0 + kr + 32 * i) * N + n0 + 4 * cg);
#pragma unroll
            for (int j = 0; j < 4; ++j) tile[(4 * cg + j) * 72 + kr + 32 * i] = f2bf(v[j]); }
        __syncthreads();
        { const u32x4 v = *(const LAS u32x4*)(tile + wn * 72 + 8 * wk); *(u32x4*)(dst + (size_t)(n0 + wn) * D + k0 + 8 * wk) = v; }
        __syncthreads();
    }
}
__device__ __forceinline__ void p0_convert(const Ctx& C, const float* src, bf16_t* dst, size_t n) {
    const size_t stride = (size_t)C.G * 512 * 8;
    for (size_t i = ((size_t)C.bid * 512 + C.tid) * 8; i < n; i += stride) {
        const f32x4 a = *(const f32x4*)(src + i), b = *(const f32x4*)(src + i + 4);
        u32x4 o; o[0] = cvt_pk_bf16(a[0], a[1]); o[1] = cvt_pk_bf16(a[2], a[3]); o[2] = cvt_pk_bf16(b[0], b[1]); o[3] = cvt_pk_bf16(b[2], b[3]);
        *(u32x4*)(dst + i) = o; }
}
__device__ __forceinline__ void p0_convert_fp8(const Ctx& C, const float* src, unsigned char* dst, size_t n, float scale) {
    const size_t stride = (size_t)C.G * 512 * 16;
    for (size_t i = ((size_t)C.bid * 512 + C.tid) * 16; i < n; i += stride) {
        u32x4 o;
#pragma unroll
        for (int q = 0; q < 4; ++q) { const f32x4 a = *(const f32x4*)(src + i + 4 * q);
            int w = __builtin_amdgcn_cvt_pk_fp8_f32(a[0] * scale, a[1] * scale, 0, false); w = __builtin_amdgcn_cvt_pk_fp8_f32(a[2] * scale, a[3] * scale, w, true); o[q] = (unsigned)w; }
        *(u32x4*)(dst + i) = o; }
}
__device__ __forceinline__ void p0_ada(const Ctx& C, const Params& P) {
    float* mod = (float*)(P.ws + WS_MOD);
    LAS float* red = (LAS float*)C.lds;
    const int cgp = C.tid % 24, ks = C.tid / 24;
    for (int cb = C.bid; cb < 256; cb += C.G) {
        const int l = cb >> 7, col0 = (cb & 127) * 96;
        if (ks < 21) {
            f32x4 a0 = {0.f, 0.f, 0.f, 0.f}, a1 = {0.f, 0.f, 0.f, 0.f};
            const float* wp = P.w_ada + (size_t)l * D * MOD6 + col0 + 4 * cgp;
            for (int k = ks; k < D; k += 21) {
                const f32x4 w = *(const f32x4*)(wp + (size_t)k * MOD6);
                const float c0 = P.c[k], c1 = P.c[D + k];
                const float s0 = c0 / (1.f + __expf(-c0)), s1 = c1 / (1.f + __expf(-c1));
                a0 += w * s0; a1 += w * s1; }
            *(LAS f32x4*)(red + (ks * 2 + 0) * 96 + 4 * cgp) = a0; *(LAS f32x4*)(red + (ks * 2 + 1) * 96 + 4 * cgp) = a1;
        }
        __syncthreads();
        if (C.tid < 192) { const int b = C.tid / 96, j = C.tid % 96; float s = P.b_ada[(size_t)l * MOD6 + col0 + j];
            for (int q = 0; q < 21; ++q) s += red[(q * 2 + b) * 96 + j];
            mod[((size_t)l * 2 + b) * MOD6 + col0 + j] = s; }
        __syncthreads();
    }
}
__device__ __forceinline__ void p0_bias(const Ctx& C, const Params& P) {
    float* biasd = (float*)(P.ws + WS_BIASD);
    if (C.bid == (C.G > 1 ? 1 : 0)) {
        for (int i = C.tid; i < 3 * 16 * 129; i += 512) {
            const int delta = i % 129, gh = i / 129, h = gh & 15, g = gh >> 4;
            const int dil = (g == 0) ? 1 : (g == 1 ? 4 : 16), dist = delta * dil;
            int bucket;
            if (dist < 16) bucket = dist;
            else { const float df = (float)dist; const int lb = 16 + (int)(logf(df / 16.f) / logf(128.f) * 16.f); bucket = lb < 31 ? lb : 31; }
            biasd[(size_t)gh * 132 + delta] = P.rel_bias[bucket * 48 + g * 16 + h]; }
    }
}
__device__ __forceinline__ void p0_prologue(const Ctx& C, const Params& P) {
    p0_ada(C, P);
    p0_bias(C, P);
    p0_transpose(C, P);
    p0_convert(C, P.peer_keys, (bf16_t*)(P.ws + WS_KEYS), (size_t)2 * 8 * 2 * 128 * 128);
    p0_convert_fp8(C, P.peer_u, P.ws + WS_U, (size_t)2 * NE * D, U_SCALE);
    p0_convert_fp8(C, P.peer_v, P.ws + WS_V, (size_t)2 * NE * D, V_SCALE);
}

__device__ __forceinline__ void norm_mod_phase(const Ctx& C, const float* hin, const float* gain, const float* shift, const float* scale, bf16_t* out) {
    const int gw = C.bid * 8 + C.wave, nw = C.G * 8;
    for (int row = gw; row < T; row += nw) {
        const int b = row >> 12;
        const float* hp = hin + (size_t)row * D;
        f32x4 v[8]; float ss = 0.f;
#pragma unroll
        for (int j = 0; j < 8; ++j) { v[j] = *(const f32x4*)(hp + (C.lane + 64 * j) * 4); ss += v[j][0] * v[j][0] + v[j][1] * v[j][1] + v[j][2] * v[j][2] + v[j][3] * v[j][3]; }
        ss = wave_sum(ss);
        const float r = rsqrtf(ss * (1.f / D) + EPS);
#pragma unroll
        for (int j = 0; j < 8; ++j) { const int col = (C.lane + 64 * j) * 4;
            const f32x4 g = *(const f32x4*)(gain + col), sh = *(const f32x4*)(shift + (size_t)b * MOD6 + col), sc = *(const f32x4*)(scale + (size_t)b * MOD6 + col);
            const f32x4 y = (v[j] * r * g) * (sc + 1.f) + sh;
            u32x2 o; o[0] = cvt_pk_bf16(y[0], y[1]); o[1] = cvt_pk_bf16(y[2], y[3]);
            *(u32x2*)(out + (size_t)row * D + col) = o; }
    }
}
constexpr int KP = 272, VP = 320;
constexpr int AW_K = 0, AW_V = 32 * KP, AW_BIAS = AW_V + 32 * VP, AW_BYTES = AW_BIAS + 544;
static_assert(AW_BYTES * 8 <= LDS_BYTES, "attention LDS");

__device__ __forceinline__ void tile_load(u32x4 (&r)[8], const bf16_t* base, size_t row_stride, int lane) {
#pragma unroll
    for (int c = 0; c < 8; ++c) r[c] = *(const u32x4*)(base + (size_t)((lane >> 4) + 4 * c) * row_stride + (lane & 15) * 8);
}
__device__ __forceinline__ void tile_write(LAS unsigned char* dst, int pitch, const u32x4 (&r)[8], int lane) {
#pragma unroll
    for (int c = 0; c < 8; ++c) *(LAS u32x4*)(dst + ((lane >> 4) + 4 * c) * pitch + (lane & 15) * 16) = r[c];
}
__device__ __forceinline__ void tile_rownorm(u32x4 (&r)[8], const float (&gn)[8]) {
#pragma unroll
    for (int c = 0; c < 8; ++c) {
        float v[8];
#pragma unroll
        for (int j = 0; j < 4; ++j) { v[2 * j] = bf_lo(r[c][j]); v[2 * j + 1] = bf_hi(r[c][j]); }
        float ss = 0.f;
#pragma unroll
        for (int j = 0; j < 8; ++j) ss += v[j] * v[j];
        ss = row16_sum(ss);
        const float sc = rsqrtf(ss * (1.f / 128.f) + EPS);
#pragma unroll
        for (int j = 0; j < 4; ++j) r[c][j] = cvt_pk_bf16(v[2 * j] * sc * gn[2 * j], v[2 * j + 1] * sc * gn[2 * j + 1]);
    }
}
__device__ __forceinline__ f32x16 qk_tile(const LAS unsigned char* Kl, const bf16x8 (&qf)[8], int r32, int hh) {
    f32x16 S;
#pragma unroll
    for (int i = 0; i < 16; ++i) S[i] = 0.f;
#pragma unroll
    for (int s = 0; s < 8; ++s) { const bf16x8 a = *(const LAS bf16x8*)(Kl + r32 * KP + (16 * s + 8 * hh) * 2); S = __builtin_amdgcn_mfma_f32_32x32x16_bf16(a, qf[s], S, 0, 0, 0); }
    return S;
}
__device__ __forceinline__ void pv_tile(f32x16 (&O)[4], const LAS unsigned char* Vl, const f32x16& Pm, int lane) {
    bf16x8 pf[2];
#pragma unroll
    for (int s = 0; s < 2; ++s) {
        u32x4 w;
#pragma unroll
        for (int j = 0; j < 4; ++j) w[j] = cvt_pk_bf16(Pm[8 * s + 2 * j], Pm[8 * s + 2 * j + 1]);
        pf[s] = __builtin_bit_cast(bf16x8, w); }
    const int gi = lane >> 4, hh = gi >> 1, eh = gi & 1, q = (lane >> 2) & 3, p = lane & 3;
    const LAS unsigned char* vb = Vl + (4 * hh + q) * VP + (16 * eh + 4 * p) * 2;
#pragma unroll
    for (int mt = 0; mt < 4; ++mt)
#pragma unroll
        for (int s = 0; s < 2; ++s) {
            const s16x4 lo = __builtin_amdgcn_ds_read_tr16_b64_v4i16((LAS s16x4*)(vb + s * 16 * VP + mt * 64));
            const s16x4 hi = __builtin_amdgcn_ds_read_tr16_b64_v4i16((LAS s16x4*)(vb + s * 16 * VP + 8 * VP + mt * 64));
            const bf16x8 a = {lo[0], lo[1], lo[2], lo[3], hi[0], hi[1], hi[2], hi[3]};
            O[mt] = __builtin_amdgcn_mfma_f32_32x32x16_bf16(a, pf[s], O[mt], 0, 0, 0); }
}
__device__ __forceinline__ void store_ot(bf16_t* out_row, const f32x16 (&O)[4], float scale, int hh) {
#pragma unroll
    for (int mt = 0; mt < 4; ++mt)
#pragma unroll
        for (int q4 = 0; q4 < 4; ++q4) { u32x2 o; o[0] = cvt_pk_bf16(O[mt][4 * q4] * scale, O[mt][4 * q4 + 1] * scale); o[1] = cvt_pk_bf16(O[mt][4 * q4 + 2] * scale, O[mt][4 * q4 + 3] * scale);
            *(u32x2*)(out_row + 32 * mt + 8 * q4 + 4 * hh) = o; }
}

__device__ __forceinline__ void attn_dilated_phase(const Ctx& C, const Params& P) {
    const bf16_t* qkv = (const bf16_t*)(P.ws + WS_QKV); bf16_t* og = (bf16_t*)(P.ws + WS_OG); float* lse = (float*)(P.ws + WS_LSE);
    const float* biasd = (const float*)(P.ws + WS_BIASD);
    LAS unsigned char* wl = C.lds + C.wave * AW_BYTES; LAS unsigned char* Kl = wl + AW_K; LAS unsigned char* Vl = wl + AW_V; LAS float* Bl = (LAS float*)(wl + AW_BIAS);
    const int lane = C.lane, r32 = lane & 31, hh = lane >> 5;
    const int nw = C.G * 8;
    for (int item = C.bid * 8 + C.wave; item < 3 * 4096; item += nw) {
        const int g = item >> 12, b = (item >> 11) & 1, h = (item >> 7) & 15, rj = item & 127;
        const int lg = 2 * g, dil = 1 << lg;
        const int njt = 128 >> lg, r = rj / njt, j = rj - r * njt;
        const size_t tok0 = (size_t)b * SEQ + r;
        const bf16_t* qbase = qkv + (size_t)g * 6144 + h * 128;
        for (int i = lane; i < 132; i += 64) Bl[i] = (i < 129) ? biasd[(size_t)(g * 16 + h) * 132 + i] : 0.f;
        bf16x8 qf[8];
        {
            const bf16_t* qp = qbase + (tok0 + (size_t)(32 * j + r32) * dil) * NA + 8 * hh;
            u32x4 raw[8]; float ss = 0.f;
#pragma unroll
            for (int s = 0; s < 8; ++s) { raw[s] = *(const u32x4*)(qp + 16 * s);
#pragma unroll
                for (int k = 0; k < 4; ++k) { const float a = bf_lo(raw[s][k]), c = bf_hi(raw[s][k]); ss += a * a + c * c; } }
            ss = half_swap_sum(ss);
            const float sc = rsqrtf(ss * (1.f / 128.f) + EPS) * 0.08838834764831845f;
            const float* gq = P.a_q_gain + g * 128 + 8 * hh;
#pragma unroll
            for (int s = 0; s < 8; ++s) { const f32x4 g0 = *(const f32x4*)(gq + 16 * s), g1 = *(const f32x4*)(gq + 16 * s + 4);
                u32x4 w;
                w[0] = cvt_pk_bf16(bf_lo(raw[s][0]) * sc * g0[0], bf_hi(raw[s][0]) * sc * g0[1]); w[1] = cvt_pk_bf16(bf_lo(raw[s][1]) * sc * g0[2], bf_hi(raw[s][1]) * sc * g0[3]);
                w[2] = cvt_pk_bf16(bf_lo(raw[s][2]) * sc * g1[0], bf_hi(raw[s][2]) * sc * g1[1]); w[3] = cvt_pk_bf16(bf_lo(raw[s][3]) * sc * g1[2], bf_hi(raw[s][3]) * sc * g1[3]);
                qf[s] = __builtin_bit_cast(bf16x8, w); }
        }
        float gk[8];
        { const float* gp = P.a_k_gain + g * 128 + 8 * (lane & 15); const f32x4 a = *(const f32x4*)gp, c = *(const f32x4*)(gp + 4);
          gk[0] = a[0]; gk[1] = a[1]; gk[2] = a[2]; gk[3] = a[3]; gk[4] = c[0]; gk[5] = c[1]; gk[6] = c[2]; gk[7] = c[3]; }
        f32x16 O[4];
#pragma unroll
        for (int mt = 0; mt < 4; ++mt)
#pragma unroll
            for (int i = 0; i < 16; ++i) O[mt][i] = 0.f;
        float m = -1e30f, l = 0.f;
        const int i0 = (j >= 4) ? 0 : 4 - j;
        for (int i = i0; i < 5; ++i) {
            const int lk0 = 32 * (j - 4 + i);
            const bf16_t* kp = qbase + 2048 + (tok0 + (size_t)lk0 * dil) * NA;
            u32x4 kr[8], vr[8];
            tile_load(kr, kp, (size_t)dil * NA, lane); tile_load(vr, kp + 2048, (size_t)dil * NA, lane);
            tile_rownorm(kr, gk);
            tile_write(Kl, KP, kr, lane); tile_write(Vl, VP, vr, lane);
            f32x16 S = qk_tile(Kl, qf, r32, hh);
            const int dbase = 128 - 32 * i + r32;
            float mx = -1e30f;
#pragma unroll
            for (int c = 0; c < 16; ++c) { const int kk = (c & 3) + 8 * (c >> 2) + 4 * hh, delta = dbase - kk;
                const bool ok = (delta >= 0) && (delta <= 128);
                const float bv = Bl[ok ? delta : 0];
                const float v = ok ? S[c] + bv : -1e30f; S[c] = v; mx = fmaxf(mx, v); }
            mx = half_swap_max(mx);
            const float mn = fmaxf(m, mx), alpha = __expf(m - mn);
            float rs = 0.f;
#pragma unroll
            for (int c = 0; c < 16; ++c) { const float p = __expf(S[c] - mn); S[c] = p; rs += p; }
            rs = half_swap_sum(rs);
            l = l * alpha + rs; m = mn;
#pragma unroll
            for (int mt = 0; mt < 4; ++mt)
#pragma unroll
                for (int c = 0; c < 16; ++c) O[mt][c] *= alpha;
            pv_tile(O, Vl, S, lane);
        }
        const size_t tq = tok0 + (size_t)(32 * j + r32) * dil;
        store_ot(og + ((size_t)g * T + tq) * D + h * 128, O, 1.f / l, hh);
        if (hh == 0) lse[((size_t)g * T + tq) * 16 + h] = m + __logf(l);
    }
}

__device__ __forceinline__ void combine_phase(const Ctx& C, const Params& P) {
    const bf16_t* og = (const bf16_t*)(P.ws + WS_OG); const float* lse = (const float*)(P.ws + WS_LSE); bf16_t* y = (bf16_t*)(P.ws + WS_Y);
    const size_t n8 = (size_t)T * D / 8, stride = (size_t)C.G * 512;
    for (size_t i = (size_t)C.bid * 512 + C.tid; i < n8; i += stride) {
        const size_t t = i >> 8; const int h = (int)(i & 255) >> 4;
        const float l0 = lse[(0 * (size_t)T + t) * 16 + h], l1 = lse[(1 * (size_t)T + t) * 16 + h], l2 = lse[(2 * (size_t)T + t) * 16 + h];
        const float mx = fmaxf(l0, fmaxf(l1, l2)); const float e0 = __expf(l0 - mx), e1 = __expf(l1 - mx), e2 = __expf(l2 - mx), inv = 1.f / (e0 + e1 + e2);
        const float a0 = e0 * inv, a1 = e1 * inv, a2 = e2 * inv;
        const u32x4 v0 = *(const u32x4*)(og + i * 8), v1 = *(const u32x4*)(og + (size_t)T * D + i * 8), v2 = *(const u32x4*)(og + 2 * (size_t)T * D + i * 8);
        u32x4 o;
#pragma unroll
        for (int k = 0; k < 4; ++k) o[k] = cvt_pk_bf16(a0 * bf_lo(v0[k]) + a1 * bf_lo(v1[k]) + a2 * bf_lo(v2[k]), a0 * bf_hi(v0[k]) + a1 * bf_hi(v1[k]) + a2 * bf_hi(v2[k]));
        *(u32x4*)(y + i * 8) = o; }
}

constexpr float SB_STOP = 110.f;
__device__ __forceinline__ void attn_stick_phase(const Ctx& C, const Params& P) {
    const bf16_t* qkv = (const bf16_t*)(P.ws + WS_QKV); bf16_t* y = (bf16_t*)(P.ws + WS_Y);
    LAS unsigned char* wl = C.lds + C.wave * AW_BYTES; LAS unsigned char* Kl = wl + AW_K; LAS unsigned char* Vl = wl + AW_V;
    const int lane = C.lane, r32 = lane & 31, hh = lane >> 5;
    const int nw = C.G * 8;
    for (int item = C.bid * 8 + C.wave; item < 4096; item += nw) {
        const int b = item >> 11, h = (item >> 7) & 15, qt = item & 127;
        const bf16_t* base = qkv + (size_t)b * SEQ * NBP + h * 128;
        bf16x8 qf[8];
        { const bf16_t* qp = base + (size_t)(32 * qt + r32) * NBP + 8 * hh;
#pragma unroll
          for (int s = 0; s < 8; ++s) { const u32x4 raw = *(const u32x4*)(qp + 16 * s); u32x4 w;
#pragma unroll
              for (int k = 0; k < 4; ++k) w[k] = cvt_pk_bf16(bf_lo(raw[k]) * 0.08838834764831845f, bf_hi(raw[k]) * 0.08838834764831845f);
              qf[s] = __builtin_bit_cast(bf16x8, w); } }
        f32x16 O[4];
#pragma unroll
        for (int mt = 0; mt < 4; ++mt)
#pragma unroll
            for (int i = 0; i < 16; ++i) O[mt][i] = 0.f;
        float carry = 0.f;
        for (int kt = qt; kt >= 0; --kt) {
            const bf16_t* kp = base + 2048 + (size_t)(32 * kt) * NBP;
            u32x4 kr[8], vr[8];
            tile_load(kr, kp, NBP, lane); tile_load(vr, kp + 2048, NBP, lane);
            tile_write(Kl, KP, kr, lane); tile_write(Vl, VP, vr, lane);
            f32x16 S = qk_tile(Kl, qf, r32, hh);
            const int lim = (kt == qt) ? r32 : 32;
            float sp[16], cs[4];
#pragma unroll
            for (int q4 = 0; q4 < 4; ++q4) { cs[q4] = 0.f;
#pragma unroll
                for (int e = 0; e < 4; ++e) { const int c = 4 * q4 + e, kk = e + 8 * q4 + 4 * hh; const float z = S[c];
                    const float s = (kk < lim) ? fmaxf(z, 0.f) + __logf(1.f + __expf(-fabsf(z))) : 0.f; sp[c] = s; cs[q4] += s; } }
            float pcs[4];
#pragma unroll
            for (int q4 = 0; q4 < 4; ++q4) { auto t2 = __builtin_amdgcn_permlane32_swap(__float_as_uint(cs[q4]), __float_as_uint(cs[q4]), false, false);
                pcs[q4] = hh ? __uint_as_float(t2[0]) : __uint_as_float(t2[1]); }
            float after = carry;
#pragma unroll
            for (int q4 = 3; q4 >= 0; --q4) {
                const float aft_chunk = after + (hh ? 0.f : pcs[q4]);
                float run = aft_chunk;
#pragma unroll
                for (int e = 3; e >= 0; --e) { const int c = 4 * q4 + e, kk = e + 8 * q4 + 4 * hh; const float z = S[c];
                    const float a = (kk < lim) ? __expf(z - sp[c] - run) : 0.f; run += sp[c]; S[c] = a; }
                after += cs[q4] + pcs[q4];
            }
            carry = after;
            pv_tile(O, Vl, S, lane);
            if (__all(carry >= SB_STOP)) break;
        }
        store_ot(y + ((size_t)b * SEQ + 32 * qt + r32) * D + h * 128, O, 1.f, hh);
    }
}
__device__ __forceinline__ int okey(float v, unsigned tag, unsigned tagmask) {
    const unsigned b = (__float_as_uint(v) & ~tagmask) | tag; return (int)(b ^ ((unsigned)((int)b >> 31) & 0x7fffffffu)); }
__device__ __forceinline__ unsigned okey_bits(int k) { const unsigned b = (unsigned)k; return b ^ ((unsigned)(k >> 31) & 0x7fffffffu); }
#define CE_DESC(a, b) do { const int _mx = max(a, b), _mn = min(a, b); a = _mx; b = _mn; } while (0)
template <int N, int B> __device__ __forceinline__ void sort16_desc(int (&k)[N]) {
#pragma unroll
    for (int size = 2; size <= 16; size <<= 1)
#pragma unroll
        for (int stride = size >> 1; stride > 0; stride >>= 1)
#pragma unroll
            for (int i = 0; i < 16; ++i) { const int j = i ^ stride;
                if (j > i) { if ((i & size) == 0) { CE_DESC(k[B + i], k[B + j]); } else { CE_DESC(k[B + j], k[B + i]); } } }
}
template <int N, int A, int Bq> __device__ __forceinline__ void merge16_desc(int (&k)[N]) {
#pragma unroll
    for (int i = 0; i < 16; ++i) k[A + i] = max(k[A + i], k[Bq + 15 - i]);
#pragma unroll
    for (int stride = 8; stride > 0; stride >>= 1)
#pragma unroll
        for (int i = 0; i < 16; ++i) { const int j = i ^ stride; if (j > i) { CE_DESC(k[A + i], k[A + j]); } }
}
template <int NA_, int A, int NB_, int Bq> __device__ __forceinline__ void merge16_desc2(int (&ka)[NA_], const int (&kb)[NB_]) {
#pragma unroll
    for (int i = 0; i < 16; ++i) ka[A + i] = max(ka[A + i], kb[Bq + 15 - i]);
#pragma unroll
    for (int stride = 8; stride > 0; stride >>= 1)
#pragma unroll
        for (int i = 0; i < 16; ++i) { const int j = i ^ stride; if (j > i) { CE_DESC(ka[A + i], ka[A + j]); } }
}
struct PairTab { int i[64], j[64], n; };
constexpr PairTab make_pairs() { PairTab t{}; int n = 0; for (int i = 0; i < 16; ++i) for (int j = 0; j < 16; ++j) if ((i + 1) * (j + 1) <= 16) { t.i[n] = i; t.j[n] = j; ++n; } t.n = n; return t; }

__device__ __forceinline__ void peer_topk_phase(const Ctx& C, const Params& P, int layer) {
    const bf16_t* pq = (const bf16_t*)(P.ws + WS_PQ); const bf16_t* keys = (const bf16_t*)(P.ws + WS_KEYS) + (size_t)layer * 8 * 2 * 128 * 128;
    int* seli = (int*)(P.ws + WS_SELI); float* selg = (float*)(P.ws + WS_SELG);
    const int lane = C.lane, r32 = lane & 31, hh = lane >> 5;
    const int nw = C.G * 8;
    for (int item = C.bid * 8 + C.wave; item < 256 * 8; item += nw) {
        const int tt = item >> 3, h = item & 7;
        int k[16];
        {
            const bf16_t* qp = pq + (size_t)(32 * tt + r32) * D + h * 256 + 8 * hh;
            const bf16_t* kp = keys + ((size_t)(h * 2) * 128 + r32) * 128 + 8 * hh;
#pragma unroll
            for (int nt = 0; nt < 4; ++nt) {
                f32x16 X0, X1;
#pragma unroll
                for (int i = 0; i < 16; ++i) { X0[i] = 0.f; X1[i] = 0.f; }
#pragma unroll
                for (int s = 0; s < 8; ++s) { const bf16x8 a = *(const bf16x8*)(kp + (size_t)nt * 32 * 128 + 16 * s); const bf16x8 q = *(const bf16x8*)(qp + 16 * s);
                    X0 = __builtin_amdgcn_mfma_f32_32x32x16_bf16(a, q, X0, 0, 0, 0); }
#pragma unroll
                for (int s = 0; s < 8; ++s) { const bf16x8 a = *(const bf16x8*)(kp + (size_t)(128 + nt * 32) * 128 + 16 * s); const bf16x8 q = *(const bf16x8*)(qp + 128 + 16 * s);
                    X1 = __builtin_amdgcn_mfma_f32_32x32x16_bf16(a, q, X1, 0, 0, 0); }
                int k32[32];
#pragma unroll
                for (int c = 0; c < 16; ++c) {
                    auto t2 = __builtin_amdgcn_permlane32_swap(__float_as_uint(X0[c]), __float_as_uint(X1[c]), false, false);
                    const int key0 = 32 * nt + (c & 3) + 8 * (c >> 2);
                    k32[2 * c] = okey(__uint_as_float(t2[0]), (unsigned)key0, 127u);
                    k32[2 * c + 1] = okey(__uint_as_float(t2[1]), (unsigned)(key0 + 4), 127u); }
                sort16_desc<32, 0>(k32); sort16_desc<32, 16>(k32); merge16_desc<32, 0, 16>(k32);
                if (nt == 0) {
#pragma unroll
                    for (int i = 0; i < 16; ++i) k[i] = k32[i];
                } else merge16_desc2<16, 0, 32, 0>(k, k32);
                __builtin_amdgcn_sched_barrier(0);
            }
        }
        float av[16], bv[16]; unsigned apk[4] = {0u, 0u, 0u, 0u}, bpk[4] = {0u, 0u, 0u, 0u};
#pragma unroll
        for (int i = 0; i < 16; ++i) {
            const unsigned bits = okey_bits(k[i]);
            auto t2 = __builtin_amdgcn_permlane32_swap(bits, bits, false, false);
            const unsigned ab = t2[0], bb = t2[1];
            av[i] = __uint_as_float(ab & ~127u); bv[i] = __uint_as_float(bb & ~127u);
            apk[i >> 2] |= (ab & 127u) << (8 * (i & 3)); bpk[i >> 2] |= (bb & 127u) << (8 * (i & 3)); }
        constexpr PairTab PT = make_pairs();
        int k2[64];
#pragma unroll
        for (int s = 0; s < 64; ++s) k2[s] = (s < PT.n) ? okey(av[PT.i[s < PT.n ? s : 0]] + bv[PT.j[s < PT.n ? s : 0]], (unsigned)(PT.i[s < PT.n ? s : 0] * 16 + PT.j[s < PT.n ? s : 0]), 255u) : (int)0x80000000;
        sort16_desc<64, 0>(k2); sort16_desc<64, 16>(k2); sort16_desc<64, 32>(k2); sort16_desc<64, 48>(k2);
        merge16_desc<64, 0, 16>(k2); merge16_desc<64, 32, 48>(k2); merge16_desc<64, 0, 32>(k2);
        float bs[16]; int eid[16];
#pragma unroll
        for (int w = 0; w < 16; ++w) { const unsigned bits = okey_bits(k2[w]); const unsigned code = bits & 255u, ci = code >> 4, cj = code & 15u;
            bs[w] = __uint_as_float(bits & ~255u);
            const unsigned aw = (ci >> 2) == 0 ? apk[0] : (ci >> 2) == 1 ? apk[1] : (ci >> 2) == 2 ? apk[2] : apk[3];
            const unsigned bw = (cj >> 2) == 0 ? bpk[0] : (cj >> 2) == 1 ? bpk[1] : (cj >> 2) == 2 ? bpk[2] : bpk[3];
            eid[w] = (int)(((aw >> (8 * (ci & 3))) & 127u) * 128u + ((bw >> (8 * (cj & 3))) & 127u)); }
        float sum = 0.f; const float bmax = bs[0];
#pragma unroll
        for (int w = 0; w < 16; ++w) { bs[w] = __expf(bs[w] - bmax); sum += bs[w]; }
        const float inv = 1.f / sum;
        if (hh == 0) {
            int* ip = seli + (size_t)(32 * tt + r32) * 128 + h * 16; float* gp = selg + (size_t)(32 * tt + r32) * 128 + h * 16;
#pragma unroll
            for (int w = 0; w < 16; w += 4) { *(int4*)(ip + w) = make_int4(eid[w], eid[w + 1], eid[w + 2], eid[w + 3]);
                *(f32x4*)(gp + w) = (f32x4){bs[w] * inv, bs[w + 1] * inv, bs[w + 2] * inv, bs[w + 3] * inv}; }
        }
    }
}

__device__ __forceinline__ float rl_f(float x, int l) { return __int_as_float(__builtin_amdgcn_readlane(__float_as_int(x), l)); }
__device__ __forceinline__ float gelu_exact(float v) { return 0.5f * v * (1.f + erff(v * 0.70710678118654752f)); }
__device__ __forceinline__ void peer_gather_phase(const Ctx& C, const Params& P, int layer, const float* hin, float* hout, const float* gate2) {
    const bf16_t* xf = (const bf16_t*)(P.ws + WS_XM);
    const unsigned char* U = P.ws + WS_U + (size_t)layer * NE * D; const unsigned char* V = P.ws + WS_V + (size_t)layer * NE * D;
    const int* seli = (const int*)(P.ws + WS_SELI); const float* selg = (const float*)(P.ws + WS_SELG);
    const int lane = C.lane, nw = C.G * 8;
    for (int t = C.bid * 8 + C.wave; t < T; t += nw) {
        f32x2 xv[16];
#pragma unroll
        for (int c = 0; c < 2; ++c)
#pragma unroll
            for (int q = 0; q < 2; ++q) { const u32x4 r = *(const u32x4*)(xf + (size_t)t * D + 1024 * c + 16 * lane + 8 * q);
#pragma unroll
                for (int j = 0; j < 4; ++j) xv[8 * c + 4 * q + j] = (f32x2){bf_lo(r[j]), bf_hi(r[j])}; }
        const int e_lo = seli[(size_t)t * 128 + lane], e_hi = seli[(size_t)t * 128 + 64 + lane];
        const float g_lo = selg[(size_t)t * 128 + lane], g_hi = selg[(size_t)t * 128 + 64 + lane];
        float w_lo = 0.f, w_hi = 0.f;
#pragma unroll 1
        for (int k0 = 0; k0 < 128; k0 += 16) {
            u32x4 ur[16][2];
#pragma unroll
            for (int q = 0; q < 16; ++q) { const int k = k0 + q; const int e = (k < 64) ? __builtin_amdgcn_readlane(e_lo, k & 63) : __builtin_amdgcn_readlane(e_hi, k & 63);
                const unsigned char* up = U + (size_t)e * D + 16 * lane;
                ur[q][0] = *(const u32x4*)up; ur[q][1] = *(const u32x4*)(up + 1024); }
#pragma unroll
            for (int q = 0; q < 16; ++q) { f32x2 d2 = {0.f, 0.f};
#pragma unroll
                for (int c = 0; c < 2; ++c)
#pragma unroll
                    for (int j = 0; j < 4; ++j) { d2 += __builtin_amdgcn_cvt_pk_f32_fp8((int)ur[q][c][j], false) * xv[8 * c + 2 * j]; d2 += __builtin_amdgcn_cvt_pk_f32_fp8((int)ur[q][c][j], true) * xv[8 * c + 2 * j + 1]; }
                const float d = wave_sum(d2.x + d2.y) * (1.f / U_SCALE);
                const int k = k0 + q; const float gk = (k < 64) ? rl_f(g_lo, k & 63) : rl_f(g_hi, k & 63);
                const float w = gelu_exact(d) * gk * (1.f / V_SCALE);
                if (k < 64) { w_lo = (lane == (k & 63)) ? w : w_lo; } else { w_hi = (lane == (k & 63)) ? w : w_hi; } }
        }
        f32x2 acc[16];
#pragma unroll
        for (int i = 0; i < 16; ++i) acc[i] = (f32x2){0.f, 0.f};
#pragma unroll 1
        for (int k0 = 0; k0 < 128; k0 += 16) {
            u32x4 vr[16][2];
#pragma unroll
            for (int q = 0; q < 16; ++q) { const int k = k0 + q; const int e = (k < 64) ? __builtin_amdgcn_readlane(e_lo, k & 63) : __builtin_amdgcn_readlane(e_hi, k & 63);
                const unsigned char* vp = V + (size_t)e * D + 16 * lane;
                vr[q][0] = *(const u32x4*)vp; vr[q][1] = *(const u32x4*)(vp + 1024); }
#pragma unroll
            for (int q = 0; q < 16; ++q) { const int k = k0 + q; const float w = (k < 64) ? rl_f(w_lo, k & 63) : rl_f(w_hi, k & 63);
#pragma unroll
                for (int c = 0; c < 2; ++c)
#pragma unroll
                    for (int j = 0; j < 4; ++j) { acc[8 * c + 2 * j] += __builtin_amdgcn_cvt_pk_f32_fp8((int)vr[q][c][j], false) * w; acc[8 * c + 2 * j + 1] += __builtin_amdgcn_cvt_pk_f32_fp8((int)vr[q][c][j], true) * w; } }
        }
        const int b = t >> 12;
#pragma unroll
        for (int c = 0; c < 2; ++c) { const size_t off = (size_t)t * D + 1024 * c + 16 * lane; const float* gp = gate2 + (size_t)b * MOD6 + 1024 * c + 16 * lane;
#pragma unroll
            for (int q = 0; q < 4; ++q) { const f32x4 hv = *(const f32x4*)(hin + off + 4 * q), gv = *(const f32x4*)(gp + 4 * q);
                f32x4 o; o[0] = hv[0] + gv[0] * acc[8 * c + 2 * q].x; o[1] = hv[1] + gv[1] * acc[8 * c + 2 * q].y; o[2] = hv[2] + gv[2] * acc[8 * c + 2 * q + 1].x; o[3] = hv[3] + gv[3] * acc[8 * c + 2 * q + 1].y;
                *(f32x4*)(hout + off + 4 * q) = o; } }
    }
}
__global__ void __launch_bounds__(512, 2) hybrid_fwd(Params P) {
    extern __shared__ __attribute__((aligned(16))) unsigned char lds_raw[];
    Ctx C; C.lds = (LAS unsigned char*)lds_raw; C.tid = threadIdx.x; C.lane = C.tid & 63; C.wave = __builtin_amdgcn_readfirstlane(C.tid >> 6); C.G = gridDim.x; C.bid = blockIdx.x;
    volatile LAS unsigned* xbw = (volatile LAS unsigned*)(C.lds + LDS_BYTES - 16);
    if (C.tid == 0) { xbw[0] = 0u; xbw[1] = 0u; xbw[2] = 0u; xbw[3] = 0u; }
    __syncthreads();
    const int lo = P.ph_lo, hi = P.ph_hi;
    const bool multi = (hi - lo) > 1;
    XcdBarrier bar; bar.bar = (unsigned*)(P.ws + WS_BAR); bar.x = 0; bar.st = xbw;
    if (multi) bar = xcd_barrier_post((unsigned*)(P.ws + WS_BAR), xbw);
#ifndef PH_MASK
#define PH_MASK 0x3ffff
#endif
#define IN(k) (lo <= (k) && (k) < hi && ((PH_MASK >> (k)) & 1))
#ifndef PH_TWICE
#define PH_TWICE 0
#endif
#define REP(k) for (int _r = 0; _r < (((PH_TWICE >> (k)) & 1) ? 2 : 1); ++_r)
#define SEAM(k) do { if (IN(k) && IN((k) + 1)) xcd_barrier(bar); } while (0)
    unsigned char* ws = P.ws;
    float* mod = (float*)(ws + WS_MOD);
    bf16_t* XM = (bf16_t*)(ws + WS_XM); float* H1 = (float*)(ws + WS_H1); float* H2 = (float*)(ws + WS_H2);
    bf16_t* QKV = (bf16_t*)(ws + WS_QKV); bf16_t* Y = (bf16_t*)(ws + WS_Y); bf16_t* PQ = (bf16_t*)(ws + WS_PQ);
    const bf16_t* WinA = (const bf16_t*)(ws + WS_WINA); const bf16_t* WinB = (const bf16_t*)(ws + WS_WINB);
    const bf16_t* Wout = (const bf16_t*)(ws + WS_WOUT); const bf16_t* Wq = (const bf16_t*)(ws + WS_WQ);

    if (IN(0)) REP(0) p0_prologue(C, P);
    SEAM(0);
    if (IN(1)) REP(1) norm_mod_phase(C, P.x, P.norm1_g, mod + 0 * D, mod + 1 * D, XM);
    SEAM(1);
    if (IN(2)) REP(2) { pg8::Gemm g{XM, WinA, T, NA, D}; pg8::StaticOrder S; S.init(T, NA, C.G, C.bid); pg8::EpiStoreBf16 E{QKV, NA}; pg8::gemm_phase(C.lds, g, S, E); }
    SEAM(2);
    if (IN(3)) REP(3) attn_dilated_phase(C, P);
    SEAM(3);
    if (IN(4)) REP(4) combine_phase(C, P);
    SEAM(4);
    if (IN(5)) REP(5) { pg8::Gemm g{Y, Wout, T, D, D}; pg8::StaticOrder S; S.init(T, D, C.G, C.bid); pg8::EpiResGate E{P.x, H1, mod + 2 * D}; pg8::gemm_phase(C.lds, g, S, E); }
    SEAM(5);
    if (IN(6)) REP(6) norm_mod_phase(C, H1, P.norm2_g, mod + 3 * D, mod + 4 * D, XM);
    SEAM(6);
    if (IN(7)) REP(7) { pg8::Gemm g{XM, Wq, T, D, D}; pg8::StaticOrder S; S.init(T, D, C.G, C.bid); pg8::EpiStoreBf16 E{PQ, D}; pg8::gemm_phase(C.lds, g, S, E); }
    SEAM(7);
    if (IN(8)) REP(8) peer_topk_phase(C, P, 0);
    SEAM(8);
    if (IN(9)) REP(9) peer_gather_phase(C, P, 0, H1, H2, mod + 5 * D);
    SEAM(9);
    float* mod1 = mod + 2 * MOD6;
    if (IN(10)) REP(10) norm_mod_phase(C, H2, P.norm1_g + D, mod1 + 0 * D, mod1 + 1 * D, XM);
    SEAM(10);
    if (IN(11)) REP(11) { pg8::Gemm g{XM, WinB, T, NBP, D}; pg8::StaticOrder S; S.init(T, NBP, C.G, C.bid); pg8::EpiStoreBf16 E{QKV, NBP}; pg8::gemm_phase(C.lds, g, S, E); }
    SEAM(11);
    if (IN(12)) REP(12) attn_stick_phase(C, P);
    SEAM(12);
    if (IN(13)) REP(13) { pg8::Gemm g{Y, Wout + (size_t)D * D, T, D, D}; pg8::StaticOrder S; S.init(T, D, C.G, C.bid); pg8::EpiResGate E{H2, H1, mod1 + 2 * D}; pg8::gemm_phase(C.lds, g, S, E); }
    SEAM(13);
    if (IN(14)) REP(14) norm_mod_phase(C, H1, P.norm2_g + D, mod1 + 3 * D, mod1 + 4 * D, XM);
    SEAM(14);
    if (IN(15)) REP(15) { pg8::Gemm g{XM, Wq + (size_t)D * D, T, D, D}; pg8::StaticOrder S; S.init(T, D, C.G, C.bid); pg8::EpiStoreBf16 E{PQ, D}; pg8::gemm_phase(C.lds, g, S, E); }
    SEAM(15);
    if (IN(16)) REP(16) peer_topk_phase(C, P, 1);
    SEAM(16);
    if (IN(17)) REP(17) peer_gather_phase(C, P, 1, H1, P.out, mod1 + 5 * D);
#undef IN
#undef REP
#undef SEAM
}

#ifndef N_LAUNCH_MODE
#define N_LAUNCH_MODE 1
#endif
constexpr int N_PHASES = 18;
extern "C" void kernel_launch(void* const* d_in, const int* in_sizes, int n_in, void* d_out, int out_size, void* d_ws, size_t ws_size, hipStream_t stream) {
    static int grid = 0;
    if (grid == 0) {
        if (n_in != 16 || out_size != T * D || ws_size < WS_END) { fprintf(stderr, "kernel_launch: unexpected sizes (n_in %d out %d ws %zu need %zu)\n", n_in, out_size, ws_size, (size_t)WS_END); grid = -1; return; }
        int dev = 0, cus = 0, per_cu = 0;
        if (hipGetDevice(&dev) != hipSuccess || hipDeviceGetAttribute(&cus, hipDeviceAttributeMultiprocessorCount, dev) != hipSuccess) { grid = -1; return; }
        if (hipFuncSetAttribute((const void*)hybrid_fwd, hipFuncAttributeMaxDynamicSharedMemorySize, LDS_BYTES) != hipSuccess) { fprintf(stderr, "kernel_launch: hipFuncSetAttribute failed\n"); grid = -1; return; }
        if (hipOccupancyMaxActiveBlocksPerMultiprocessor(&per_cu, (const void*)hybrid_fwd, 512, LDS_BYTES) != hipSuccess || per_cu < 1) { fprintf(stderr, "kernel_launch: occupancy query says %d\n", per_cu); }
        (void)hipGetLastError();
        grid = cus;
    }
    if (grid < 0) return;
    (void)hipMemsetAsync((char*)d_ws + WS_BAR, 0, 16384, stream);
    Params p{};
    p.x = (const float*)d_in[0]; p.c = (const float*)d_in[1]; p.rel_bias = (const float*)d_in[2]; p.norm1_g = (const float*)d_in[3]; p.norm2_g = (const float*)d_in[4];
    p.w_ada = (const float*)d_in[5]; p.b_ada = (const float*)d_in[6]; p.a_w_in = (const float*)d_in[7]; p.a_q_gain = (const float*)d_in[8]; p.a_k_gain = (const float*)d_in[9];
    p.b_w_in = (const float*)d_in[10]; p.w_out = (const float*)d_in[11]; p.peer_wq = (const float*)d_in[12]; p.peer_keys = (const float*)d_in[13]; p.peer_u = (const float*)d_in[14]; p.peer_v = (const float*)d_in[15];
    p.out = (float*)d_out; p.ws = (unsigned char*)d_ws;
    if (N_LAUNCH_MODE == 1) { p.ph_lo = 0; p.ph_hi = N_PHASES; hipLaunchKernelGGL(hybrid_fwd, dim3(grid), dim3(512), LDS_BYTES, stream, p); }
    else for (int k = 0; k < N_PHASES; ++k) { p.ph_lo = k; p.ph_hi = k + 1; hipLaunchKernelGGL(hybrid_fwd, dim3(grid), dim3(512), LDS_BYTES, stream, p); }
}
```

```cpp
#include <hip/hip_runtime.h>
#include <stdint.h>
#include <stdio.h>

#define LAS __attribute__((address_space(3)))
typedef unsigned short bf16_t;
typedef short bf16x8 __attribute__((ext_vector_type(8)));
typedef short s16x4 __attribute__((ext_vector_type(4)));
typedef float f32x2 __attribute__((ext_vector_type(2)));
typedef float f32x4 __attribute__((ext_vector_type(4)));
typedef float f32x16 __attribute__((ext_vector_type(16)));
typedef unsigned u32x4 __attribute__((ext_vector_type(4)));
typedef unsigned u32x2 __attribute__((ext_vector_type(2)));

constexpr int D = 2048, NBATCH = 2, SEQ = 4096, T = NBATCH * SEQ;
constexpr int NA = 18432, NBP = 6144, NE = 16384, MOD6 = 6 * D;
constexpr float EPS = 1e-6f;
constexpr float U_SCALE = 512.f, V_SCALE = 32.f;

constexpr size_t MB = 1024 * 1024;
constexpr size_t WS_BAR = 0;
constexpr size_t WS_MOD = 16384;
constexpr size_t WS_BIASD = WS_MOD + 2 * 2 * MOD6 * 4;
constexpr size_t WS_WINA = 1 * MB;
constexpr size_t WS_WINB = WS_WINA + (size_t)NA * D * 2;
constexpr size_t WS_WOUT = WS_WINB + (size_t)NBP * D * 2;
constexpr size_t WS_WQ = WS_WOUT + (size_t)2 * D * D * 2;
constexpr size_t WS_KEYS = WS_WQ + (size_t)2 * D * D * 2;
constexpr size_t WS_U = WS_KEYS + (size_t)2 * 8 * 2 * 128 * 128 * 2;
constexpr size_t WS_V = WS_U + (size_t)2 * NE * D;
constexpr size_t WS_XM = WS_V + (size_t)2 * NE * D;
constexpr size_t WS_H1 = WS_XM + (size_t)T * D * 2;
constexpr size_t WS_H2 = WS_H1 + (size_t)T * D * 4;
constexpr size_t WS_OG = WS_H2 + (size_t)T * D * 4;
constexpr size_t WS_LSE = WS_OG + (size_t)3 * T * D * 2;
constexpr size_t WS_QKV = WS_LSE + (size_t)3 * T * 16 * 4;
constexpr size_t WS_Y = WS_QKV + 112 * MB;
constexpr size_t WS_PQ = WS_Y + (size_t)T * D * 2;
constexpr size_t WS_SELI = WS_PQ + (size_t)T * D * 2;
constexpr size_t WS_SELG = WS_SELI + (size_t)T * 128 * 4;
constexpr size_t WS_END = WS_QKV + (size_t)T * NA * 2;
static_assert(WS_SELG + (size_t)T * 128 * 4 <= WS_END, "aliases must fit inside the qkv region");
static_assert(WS_QKV + (size_t)T * NBP * 2 <= WS_Y, "layer-1 qkv must not overlap y");

constexpr int LDS_BYTES = 159 * 1024;

__device__ __forceinline__ unsigned cvt_pk_bf16(float lo, float hi) { unsigned r; asm volatile("v_cvt_pk_bf16_f32 %0, %1, %2" : "=v"(r) : "v"(lo), "v"(hi)); return r; }
__device__ __forceinline__ float bf_lo(unsigned u) { return __uint_as_float(u << 16); }
__device__ __forceinline__ float bf_hi(unsigned u) { return __uint_as_float(u & 0xffff0000u); }
__device__ __forceinline__ bf16_t f2bf(float f) { unsigned u = __float_as_uint(f); u += 0x7FFFu + ((u >> 16) & 1u); return (bf16_t)(u >> 16); }
template <int CTRL> __device__ __forceinline__ float dppf(float x) { return __builtin_bit_cast(float, __builtin_amdgcn_mov_dpp(__builtin_bit_cast(int, x), CTRL, 0xf, 0xf, true)); }
__device__ __forceinline__ float row16_sum(float x) { x += dppf<0xB1>(x); x += dppf<0x4E>(x); x += dppf<0x141>(x); x += dppf<0x140>(x); return x; }
__device__ __forceinline__ float half_swap_sum(float x) { auto t = __builtin_amdgcn_permlane32_swap(__float_as_uint(x), __float_as_uint(x), false, false); return __uint_as_float(t[0]) + __uint_as_float(t[1]); }
__device__ __forceinline__ float half_swap_max(float x) { auto t = __builtin_amdgcn_permlane32_swap(__float_as_uint(x), __float_as_uint(x), false, false); return fmaxf(__uint_as_float(t[0]), __uint_as_float(t[1])); }
__device__ __forceinline__ float wave_sum(float x) { x = row16_sum(x); x += __shfl_xor(x, 16); x = half_swap_sum(x); return x; }
#define XB_TMO      128
#define XB_XCNT(j)  (256  + 64 * (j))
#define XB_XSUB(j)  (1280 + 64 * (j))
#define XB_XGEN(j)  (2304 + 64 * (j))
#define XB_TOP      3328
#define XB_TOPGEN   3392
#define XCD_BAR_WORDS 3456
#define XB_SPIN_CAP (1u << 18)

__device__ __forceinline__ unsigned xb_ld(unsigned* p)              { return __hip_atomic_load(p, __ATOMIC_RELAXED, __HIP_MEMORY_SCOPE_AGENT); }
__device__ __forceinline__ unsigned xb_add(unsigned* p, unsigned v) { return __hip_atomic_fetch_add(p, v, __ATOMIC_RELAXED, __HIP_MEMORY_SCOPE_AGENT); }
__device__ __forceinline__ unsigned xb_xcc_id() { return (unsigned)__builtin_amdgcn_s_getreg((3 << 11) | 20) & 0xFu; }
#define XB_SPIN(cond, bar) do { unsigned _sp = 0; while (cond) { __builtin_amdgcn_s_sleep(1); \
    if ((++_sp & 255u) == 0u) { if (xb_ld(&(bar)[XB_TMO])) break; if (_sp > XB_SPIN_CAP) { atomicAdd(&(bar)[XB_TMO], 1u); break; } } } } while (0)

struct XcdBarrier {
    unsigned* bar; unsigned x;
    volatile LAS unsigned* st;
};

__device__ __forceinline__ XcdBarrier xcd_barrier_post(unsigned* bar, volatile LAS unsigned* st) {
    XcdBarrier b; b.bar = bar; b.x = xb_xcc_id(); b.st = st;
    if (threadIdx.x == 0) (void)xb_add(&bar[XB_XCNT(b.x)], 1u);
    return b;
}
__device__ __forceinline__ void xcd_barrier_complete(unsigned* bar, unsigned x, unsigned& nloc, unsigned& nx) {
    const unsigned G = gridDim.x * gridDim.y * gridDim.z;
    unsigned sum, cnt, mine, sp = 0u;
    for (;;) {
        sum = 0u; cnt = 0u; mine = 0u;
#pragma unroll
        for (unsigned j = 0; j < 16; ++j) { const unsigned c = xb_ld(&bar[XB_XCNT(j)]); sum += c; cnt += (c > 0u) ? 1u : 0u; mine = (j == x) ? c : mine; }
        if (sum == G) break;
        __builtin_amdgcn_s_sleep(1);
        if ((++sp & 255u) == 0u) { if (xb_ld(&bar[XB_TMO])) break; if (sp > XB_SPIN_CAP) { atomicAdd(&bar[XB_TMO], 1u); break; } }
    }
    nloc = mine > 0u ? mine : 1u; nx = cnt > 0u ? cnt : 1u;
}

__device__ __forceinline__ void xcd_barrier(const XcdBarrier& b) {
    asm volatile("s_waitcnt vmcnt(0)" ::: "memory");
    __syncthreads();
    if (threadIdx.x == 0) {
        unsigned* bar = b.bar;
        __builtin_amdgcn_s_waitcnt(0);
        unsigned nloc = b.st[0], nx = b.st[1];
        if (nloc == 0u) { xcd_barrier_complete(bar, b.x, nloc, nx); b.st[0] = nloc; b.st[1] = nx; }
        const unsigned old = xb_add(&bar[XB_XSUB(b.x)], 1u);
        const unsigned gen = old / nloc;
        if (old + 1u == (gen + 1u) * nloc) {
            __builtin_amdgcn_fence(__ATOMIC_RELEASE, "agent");
            asm volatile("s_waitcnt vmcnt(0)" ::: "memory");
            const unsigned og = xb_add(&bar[XB_TOP], 1u);
            const unsigned tg = og / nx;
            if (og + 1u == (tg + 1u) * nx) xb_add(&bar[XB_TOPGEN], 1u);
            else XB_SPIN(xb_ld(&bar[XB_TOPGEN]) == tg, bar);
            __builtin_amdgcn_fence(__ATOMIC_ACQUIRE, "agent");
            xb_add(&bar[XB_XGEN(b.x)], 1u);
            asm volatile("s_waitcnt vmcnt(0)" ::: "memory");
        } else {
            XB_SPIN(xb_ld(&bar[XB_XGEN(b.x)]) == gen, bar);
            __builtin_amdgcn_fence(__ATOMIC_ACQUIRE, "agent");
            asm volatile("s_waitcnt vmcnt(0)" ::: "memory");
        }
    }
    __syncthreads();
}
namespace pg8 {
#define PG8_LAS __attribute__((address_space(3)))
constexpr int BM = 256, BK = 64, HALF = 128, HTB = HALF * BK * 2  , STAGE_BYTES = 8 * HTB, NXCD = 8, WGM = 8;

__host__ __device__ __forceinline__ int lds_byte(int r, int c) { const int st = (r >> 4) * 2 + (c >> 5), rr = r & 15, cc = c & 31, ob = rr * 64 + cc * 2; return st * 1024 + (ob ^ (((ob >> 9) & 1) << 5)); }
__host__ __device__ __forceinline__ void stage_rc(int b, int& R, int& C) { const int st = b / 1024, sb = b % 1024, swz = sb ^ (((sb >> 9) & 1) << 5); R = (st >> 1) * 16 + swz / 64; C = (st & 1) * 32 + (swz % 64) / 2; }
__host__ __device__ __forceinline__ int perm32(int rho) { const int n = rho >> 4, i = rho & 15; return 8 * (i >> 2) + 4 * n + (i & 3); }

struct Unit { int pm, pn; };
struct Gemm { const bf16_t* A; const bf16_t* Bt; int M, N, K; };

struct StaticOrder {
    int nM, nN, nwg, G, c;
    __host__ __device__ void init(int M, int N, int G_, int c_) { nM = M / BM; nN = N / BM; nwg = nM * nN; G = G_; c = c_; }
    __host__ __device__ bool next(int i, Unit& u) const {
        const long L = (long)i * G + c; if (L >= nwg) return false;
        int wgid = (int)L; { const int q = nwg / NXCD, r = nwg % NXCD, xcd = wgid % NXCD, off = wgid / NXCD; wgid = (xcd < r ? xcd * (q + 1) : r * (q + 1) + (xcd - r) * q) + off; }
        const int nig = WGM * nN, gid = wgid / nig, fm = gid * WGM, gsz = (nM - fm) < WGM ? (nM - fm) : WGM;
        u.pm = fm + ((wgid % nig) % gsz); u.pn = (wgid % nig) / gsz; return true;
    }
    __device__ __forceinline__ void a_ready(const Unit&) const {}
    __device__ __forceinline__ void done(const Unit&) const {}
};

template <class Epi, class Sched>
__device__ __forceinline__ void gemm_phase(PG8_LAS unsigned char* lds, const Gemm g, const Sched& S, const Epi& E) {
    const int tid = threadIdx.x, wid = __builtin_amdgcn_readfirstlane(tid >> 6), lane = tid & 63, wr = wid >> 2, wc = wid & 3, fr = lane & 15, fq = lane >> 4;
    const int K = g.K, nt = K / BK;
    unsigned voffA[2], voffB[2];
#pragma unroll
    for (int i = 0; i < 2; ++i) { int R, C; stage_rc(tid * 16 + i * 8192, R, C); const int Rb = Epi::PERM ? ((R & ~31) + perm32(R & 31)) : R;
        voffA[i] = (unsigned)(R * K + C) * 2u; voffB[i] = (unsigned)(Rb * K + C) * 2u; }
    const size_t kstep = (size_t)(BK * 2);
    const size_t hstep = (size_t)HALF * K * 2;
    const size_t tstep = 2 * hstep;
    const unsigned ldsw = (unsigned)wid * 1024u;
    const int aoff = lds_byte(wr * 64 + fr, fq * 8), boff = lds_byte(wc * 32 + fr, fq * 8);
#define PG8_SA(b, h) (((b) * 2 + (h)) * HTB)
#define PG8_SB(b, h) ((4 + (b) * 2 + (h)) * HTB)
#define PG8_STAGE(bufoff, gbase, voff) do { _Pragma("unroll") for (int _i = 0; _i < 2; ++_i) \
        __builtin_amdgcn_global_load_lds((const unsigned*)((const char*)(gbase) + (voff)[_i]), (PG8_LAS unsigned*)(lds + (bufoff) + ldsw + _i * 8192), 16, 0, 0); } while (0)
#define PG8_LDA(dst, b, h) do { _Pragma("unroll") for (int m = 0; m < 4; ++m) _Pragma("unroll") for (int k = 0; k < 2; ++k) dst[m][k] = *(const PG8_LAS bf16x8*)(lds + PG8_SA(b, h) + aoff + m * 2048 + k * 1024); } while (0)
#define PG8_LDB(dst, b, h) do { _Pragma("unroll") for (int n = 0; n < 2; ++n) _Pragma("unroll") for (int k = 0; k < 2; ++k) dst[n][k] = *(const PG8_LAS bf16x8*)(lds + PG8_SB(b, h) + boff + n * 2048 + k * 1024); } while (0)
#define PG8_MMA(ai, bj, At, Bt) do { __builtin_amdgcn_s_setprio(1); _Pragma("unroll") for (int m = 0; m < 4; ++m) _Pragma("unroll") for (int n = 0; n < 2; ++n) _Pragma("unroll") for (int k = 0; k < 2; ++k) \
        acc[ai][bj][m][n] = __builtin_amdgcn_mfma_f32_16x16x32_bf16(Bt[n][k], At[m][k], acc[ai][bj][m][n], 0, 0, 0); __builtin_amdgcn_s_setprio(0); } while (0)
#define PG8_WAIT_V(n) asm volatile("s_waitcnt vmcnt(" #n ")" ::: "memory")
#define PG8_WAIT_L(n) asm volatile("s_waitcnt lgkmcnt(" #n ")" ::: "memory")
#define PG8_BAR __builtin_amdgcn_s_barrier()
#define PG8_SCHED __builtin_amdgcn_sched_barrier(0)
    Unit cur, nxt; int ui = 0;
    if (!S.next(0, cur)) return;
    f32x4 acc[2][2][4][2];
#pragma unroll
    for (int a = 0; a < 2; ++a)
#pragma unroll
        for (int b = 0; b < 2; ++b)
#pragma unroll
            for (int m = 0; m < 4; ++m)
#pragma unroll
                for (int n = 0; n < 2; ++n) acc[a][b][m][n] = (f32x4){0.f, 0.f, 0.f, 0.f};
    bf16x8 At[4][2], B0[2][2], B1[2][2];
    const char* cA = (const char*)g.A + (size_t)cur.pm * tstep; const char* cB = (const char*)g.Bt + (size_t)cur.pn * tstep;
    S.a_ready(cur);
    PG8_STAGE(PG8_SB(0, 0), cB, voffB); PG8_STAGE(PG8_SA(0, 0), cA, voffA); PG8_STAGE(PG8_SB(0, 1), cB + hstep, voffB); PG8_STAGE(PG8_SA(0, 1), cA + hstep, voffA);
    if (wr == 1) PG8_BAR;
    PG8_WAIT_V(4); PG8_BAR;
    PG8_STAGE(PG8_SB(1, 0), cB + kstep, voffB); PG8_STAGE(PG8_SA(1, 0), cA + kstep, voffA); PG8_STAGE(PG8_SB(1, 1), cB + hstep + kstep, voffB);
    PG8_WAIT_V(6); PG8_BAR;
    for (;;) {
        const bool has_next = S.next(ui + 1, nxt);
        const char* nA = has_next ? (const char*)g.A + (size_t)nxt.pm * tstep : cA; const char* nB = has_next ? (const char*)g.Bt + (size_t)nxt.pn * tstep : cB;
        for (int t = 0; t < nt; t += 2) {
            const bool last = (t == nt - 2);
            const char* a1 = cA + (size_t)(t + 1) * kstep;
            const char* a2 = last ? nA : cA + (size_t)(t + 2) * kstep; const char* b2 = last ? nB : cB + (size_t)(t + 2) * kstep;
            const char* a3 = a2 + kstep; const char* b3 = b2 + kstep;
            if (last && has_next) S.a_ready(nxt);
            PG8_LDB(B0, 0, 0); PG8_SCHED; PG8_LDA(At, 0, 0); PG8_STAGE(PG8_SA(1, 1), a1 + hstep, voffA);
            PG8_WAIT_L(8); PG8_BAR; PG8_WAIT_L(0); PG8_MMA(0, 0, At, B0); PG8_BAR; PG8_SCHED;
            PG8_LDB(B1, 0, 1); PG8_STAGE(PG8_SB(0, 0), b2, voffB);
            PG8_BAR; PG8_WAIT_L(0); PG8_MMA(0, 1, At, B1); PG8_BAR;
            PG8_LDA(At, 0, 1); PG8_STAGE(PG8_SA(0, 0), a2, voffA);
            PG8_BAR; PG8_WAIT_L(0); PG8_MMA(1, 0, At, B0); PG8_BAR; PG8_SCHED;
            PG8_STAGE(PG8_SB(0, 1), b2 + hstep, voffB);
            PG8_WAIT_V(6); PG8_BAR; PG8_MMA(1, 1, At, B1); PG8_BAR;
            PG8_LDB(B0, 1, 0); PG8_SCHED; PG8_LDA(At, 1, 0); PG8_STAGE(PG8_SA(0, 1), a2 + hstep, voffA);
            PG8_WAIT_L(8); PG8_BAR; PG8_WAIT_L(0); PG8_MMA(0, 0, At, B0); PG8_BAR; PG8_SCHED;
            PG8_LDB(B1, 1, 1); PG8_STAGE(PG8_SB(1, 0), b3, voffB);
            PG8_BAR; PG8_WAIT_L(0); PG8_MMA(0, 1, At, B1); PG8_BAR;
            PG8_LDA(At, 1, 1); PG8_STAGE(PG8_SA(1, 0), a3, voffA);
            PG8_BAR; PG8_WAIT_L(0); PG8_MMA(1, 0, At, B0); PG8_BAR; PG8_SCHED;
            PG8_STAGE(PG8_SB(1, 1), b3 + hstep, voffB);
            PG8_WAIT_V(6); PG8_BAR; PG8_MMA(1, 1, At, B1); PG8_BAR;
        }
        if constexpr (!Epi::AFTER_DRAIN) { E(acc, cur, wr, wc, fr, fq); S.done(cur); }
        if (!has_next) break;
#pragma unroll
        for (int a = 0; a < 2; ++a)
#pragma unroll
            for (int b = 0; b < 2; ++b)
#pragma unroll
                for (int m = 0; m < 4; ++m)
#pragma unroll
                    for (int n = 0; n < 2; ++n) acc[a][b][m][n] = (f32x4){0.f, 0.f, 0.f, 0.f};
        cur = nxt; cA = nA; cB = nB; ++ui;
    }
    PG8_WAIT_V(0);
    if (wr == 0) PG8_BAR;
    PG8_BAR;
    if constexpr (Epi::AFTER_DRAIN) { E.fused(acc, cur, wr, wc, fr, fq, lds, wid, lane); S.done(cur); }
#undef PG8_SA
#undef PG8_SB
#undef PG8_STAGE
#undef PG8_LDA
#undef PG8_LDB
#undef PG8_MMA
#undef PG8_WAIT_V
#undef PG8_WAIT_L
#undef PG8_BAR
#undef PG8_SCHED
}
}
namespace pg8 {
struct EpiStoreBf16 {
    static constexpr bool PERM = true, AFTER_DRAIN = false;
    bf16_t* O; int ldc;
    __device__ __forceinline__ void operator()(const f32x4 (&acc)[2][2][4][2], const Unit& u, int wr, int wc, int fr, int fq) const {
        const int row0 = u.pm * BM + wr * 64 + fr, col0 = u.pn * BM + wc * 32 + 8 * fq;
#pragma unroll
        for (int ai = 0; ai < 2; ++ai)
#pragma unroll
            for (int m = 0; m < 4; ++m) { bf16_t* rowp = O + (size_t)(row0 + ai * HALF + m * 16) * ldc + col0;
#pragma unroll
                for (int bj = 0; bj < 2; ++bj) { const f32x4 v0 = acc[ai][bj][m][0], v1 = acc[ai][bj][m][1];
                    u32x4 o; o[0] = cvt_pk_bf16(v0[0], v0[1]); o[1] = cvt_pk_bf16(v0[2], v0[3]); o[2] = cvt_pk_bf16(v1[0], v1[1]); o[3] = cvt_pk_bf16(v1[2], v1[3]);
                    *(u32x4*)(rowp + bj * HALF) = o; } }
    }
};
struct EpiResGate {
    static constexpr bool PERM = false, AFTER_DRAIN = false;
    const float* Hin; float* Hout; const float* gate;
    __device__ __forceinline__ void operator()(const f32x4 (&acc)[2][2][4][2], const Unit& u, int wr, int wc, int fr, int fq) const {
        const int row0 = u.pm * BM + wr * 64 + fr, col0 = u.pn * BM + wc * 32 + 4 * fq;
        const float* gp = gate + (size_t)(u.pm >> 4) * MOD6 + col0;
        f32x4 gv[2][2];
#pragma unroll
        for (int bj = 0; bj < 2; ++bj)
#pragma unroll
            for (int n = 0; n < 2; ++n) gv[bj][n] = *(const f32x4*)(gp + bj * HALF + n * 16);
#pragma unroll
        for (int ai = 0; ai < 2; ++ai)
#pragma unroll
            for (int m = 0; m < 4; ++m) { const size_t ro = (size_t)(row0 + ai * HALF + m * 16) * D + col0;
#pragma unroll
                for (int bj = 0; bj < 2; ++bj)
#pragma unroll
                    for (int n = 0; n < 2; ++n) { const f32x4 h = *(const f32x4*)(Hin + ro + bj * HALF + n * 16);
                        *(f32x4*)(Hout + ro + bj * HALF + n * 16) = h + gv[bj][n] * acc[ai][bj][m][n]; } }
    }
};
}

struct Params {
    const float *x, *c, *rel_bias, *norm1_g, *norm2_g, *w_ada, *b_ada, *a_w_in, *a_q_gain, *a_k_gain, *b_w_in, *w_out, *peer_wq, *peer_keys, *peer_u, *peer_v;
    float* out; unsigned char* ws; int ph_lo, ph_hi;
};
struct Ctx { LAS unsigned char* lds; int tid, lane, wave, G, bid; };

__device__ __forceinline__ void p0_transpose(const Ctx& C, const Params& P) {
    bf16_t* WinA = (bf16_t*)(P.ws + WS_WINA); bf16_t* WinB = (bf16_t*)(P.ws + WS_WINB); bf16_t* Wout = (bf16_t*)(P.ws + WS_WOUT); bf16_t* Wq = (bf16_t*)(P.ws + WS_WQ);
    LAS bf16_t* tile = (LAS bf16_t*)C.lds;
    const int kr = C.tid >> 4, cg = C.tid & 15, wn = C.tid >> 3, wk = C.tid & 7;
    for (int ti = C.bid; ti < 16384; ti += C.G) {
        const float* src; bf16_t* dst; int N; int loc = ti;
        if (loc < 9216) { src = P.a_w_in; dst = WinA; N = NA; }
        else if (loc < 9216 + 3072) { loc -= 9216; src = P.b_w_in; dst = WinB; N = NBP; }
        else { loc -= 9216 + 3072; const int m = loc >> 10; loc &= 1023; N = D;
               src = (m < 2) ? P.w_out + (size_t)m * D * D : P.peer_wq + (size_t)(m - 2) * D * D; dst = (m < 2) ? Wout + (size_t)m * D * D : Wq + (size_t)(m - 2) * D * D; }
        const int ntl = N >> 6, kt = loc / ntl, nt = loc - kt * ntl, k0 = kt * 64, n0 = nt * 64;
#pragma unroll
        for (int i = 0; i < 2; ++i) { const f32x4 v = *(const f32x4*)(src + (size_t)(k0 + kr + 32 * i) * N + n0 + 4 * cg);
#pragma unroll
            for (int j = 0; j < 4; ++j) tile[(4 * cg + j) * 72 + kr + 32 * i] = f2bf(v[j]); }
        __syncthreads();
        { const u32x4 v = *(const LAS u32x4*)(tile + wn * 72 + 8 * wk); *(u32x4*)(dst + (size_t)(n0 + wn) * D + k0 + 8 * wk) = v; }
        __syncthreads();
    }
}
__device__ __forceinline__ void p0_convert(const Ctx& C, const float* src, bf16_t* dst, size_t n) {
    const size_t stride = (size_t)C.G * 512 * 8;
    for (size_t i = ((size_t)C.bid * 512 + C.tid) * 8; i < n; i += stride) {
        const f32x4 a = *(const f32x4*)(src + i), b = *(const f32x4*)(src + i + 4);
        u32x4 o; o[0] = cvt_pk_bf16(a[0], a[1]); o[1] = cvt_pk_bf16(a[2], a[3]); o[2] = cvt_pk_bf16(b[0], b[1]); o[3] = cvt_pk_bf16(b[2], b[3]);
        *(u32x4*)(dst + i) = o; }
}
__device__ __forceinline__ void p0_convert_fp8(const Ctx& C, const float* src, unsigned char* dst, size_t n, float scale) {
    const size_t stride = (size_t)C.G * 512 * 16;
    for (size_t i = ((size_t)C.bid * 512 + C.tid) * 16; i < n; i += stride) {
        u32x4 o;
#pragma unroll
        for (int q = 0; q < 4; ++q) { const f32x4 a = *(const f32x4*)(src + i + 4 * q);
            int w = __builtin_amdgcn_cvt_pk_fp8_f32(a[0] * scale, a[1] * scale, 0, false); w = __builtin_amdgcn_cvt_pk_fp8_f32(a[2] * scale, a[3] * scale, w, true); o[q] = (unsigned)w; }
        *(u32x4*)(dst + i) = o; }
}
__device__ __forceinline__ void p0_ada(const Ctx& C, const Params& P) {
    float* mod = (float*)(P.ws + WS_MOD);
    LAS float* red = (LAS float*)C.lds;
    const int cgp = C.tid % 24, ks = C.tid / 24;
    for (int cb = C.bid; cb < 256; cb += C.G) {
        const int l = cb >> 7, col0 = (cb & 127) * 96;
        if (ks < 21) {
            f32x4 a0 = {0.f, 0.f, 0.f, 0.f}, a1 = {0.f, 0.f, 0.f, 0.f};
            const float* wp = P.w_ada + (size_t)l * D * MOD6 + col0 + 4 * cgp;
            for (int k = ks; k < D; k += 21) {
                const f32x4 w = *(const f32x4*)(wp + (size_t)k * MOD6);
                const float c0 = P.c[k], c1 = P.c[D + k];
                const float s0 = c0 / (1.f + __expf(-c0)), s1 = c1 / (1.f + __expf(-c1));
                a0 += w * s0; a1 += w * s1; }
            *(LAS f32x4*)(red + (ks * 2 + 0) * 96 + 4 * cgp) = a0; *(LAS f32x4*)(red + (ks * 2 + 1) * 96 + 4 * cgp) = a1;
        }
        __syncthreads();
        if (C.tid < 192) { const int b = C.tid / 96, j = C.tid % 96; float s = P.b_ada[(size_t)l * MOD6 + col0 + j];
            for (int q = 0; q < 21; ++q) s += red[(q * 2 + b) * 96 + j];
            mod[((size_t)l * 2 + b) * MOD6 + col0 + j] = s; }
        __syncthreads();
    }
}
__device__ __forceinline__ void p0_bias(const Ctx& C, const Params& P) {
    float* biasd = (float*)(P.ws + WS_BIASD);
    if (C.bid == (C.G > 1 ? 1 : 0)) {
        for (int i = C.tid; i < 3 * 16 * 129; i += 512) {
            const int delta = i % 129, gh = i / 129, h = gh & 15, g = gh >> 4;
            const int dil = (g == 0) ? 1 : (g == 1 ? 4 : 16), dist = delta * dil;
            int bucket;
            if (dist < 16) bucket = dist;
            else { const float df = (float)dist; const int lb = 16 + (int)(logf(df / 16.f) / logf(128.f) * 16.f); bucket = lb < 31 ? lb : 31; }
            biasd[(size_t)gh * 132 + delta] = P.rel_bias[bucket * 48 + g * 16 + h]; }
    }
}
__device__ __forceinline__ void p0_prologue(const Ctx& C, const Params& P) {
    p0_ada(C, P);
    p0_bias(C, P);
    p0_transpose(C, P);
    p0_convert(C, P.peer_keys, (bf16_t*)(P.ws + WS_KEYS), (size_t)2 * 8 * 2 * 128 * 128);
    p0_convert_fp8(C, P.peer_u, P.ws + WS_U, (size_t)2 * NE * D, U_SCALE);
    p0_convert_fp8(C, P.peer_v, P.ws + WS_V, (size_t)2 * NE * D, V_SCALE);
}

__device__ __forceinline__ void norm_mod_phase(const Ctx& C, const float* hin, const float* gain, const float* shift, const float* scale, bf16_t* out) {
    const int gw = C.bid * 8 + C.wave, nw = C.G * 8;
    for (int row = gw; row < T; row += nw) {
        const int b = row >> 12;
        const float* hp = hin + (size_t)row * D;
        f32x4 v[8]; float ss = 0.f;
#pragma unroll
        for (int j = 0; j < 8; ++j) { v[j] = *(const f32x4*)(hp + (C.lane + 64 * j) * 4); ss += v[j][0] * v[j][0] + v[j][1] * v[j][1] + v[j][2] * v[j][2] + v[j][3] * v[j][3]; }
        ss = wave_sum(ss);
        const float r = rsqrtf(ss * (1.f / D) + EPS);
#pragma unroll
        for (int j = 0; j < 8; ++j) { const int col = (C.lane + 64 * j) * 4;
            const f32x4 g = *(const f32x4*)(gain + col), sh = *(const f32x4*)(shift + (size_t)b * MOD6 + col), sc = *(const f32x4*)(scale + (size_t)b * MOD6 + col);
            const f32x4 y = (v[j] * r * g) * (sc + 1.f) + sh;
            u32x2 o; o[0] = cvt_pk_bf16(y[0], y[1]); o[1] = cvt_pk_bf16(y[2], y[3]);
            *(u32x2*)(out + (size_t)row * D + col) = o; }
    }
}
constexpr int KP = 272, VP = 320;
constexpr int AW_K = 0, AW_V = 32 * KP, AW_BIAS = AW_V + 32 * VP, AW_BYTES = AW_BIAS + 544;
static_assert(AW_BYTES * 8 <= LDS_BYTES, "attention LDS");

__device__ __forceinline__ void tile_load(u32x4 (&r)[8], const bf16_t* base, size_t row_stride, int lane) {
#pragma unroll
    for (int c = 0; c < 8; ++c) r[c] = *(const u32x4*)(base + (size_t)((lane >> 4) + 4 * c) * row_stride + (lane & 15) * 8);
}
__device__ __forceinline__ void tile_write(LAS unsigned char* dst, int pitch, const u32x4 (&r)[8], int lane) {
#pragma unroll
    for (int c = 0; c < 8; ++c) *(LAS u32x4*)(dst + ((lane >> 4) + 4 * c) * pitch + (lane & 15) * 16) = r[c];
}
__device__ __forceinline__ void tile_rownorm(u32x4 (&r)[8], const float (&gn)[8]) {
#pragma unroll
    for (int c = 0; c < 8; ++c) {
        float v[8];
#pragma unroll
        for (int j = 0; j < 4; ++j) { v[2 * j] = bf_lo(r[c][j]); v[2 * j + 1] = bf_hi(r[c][j]); }
        float ss = 0.f;
#pragma unroll
        for (int j = 0; j < 8; ++j) ss += v[j] * v[j];
        ss = row16_sum(ss);
        const float sc = rsqrtf(ss * (1.f / 128.f) + EPS);
#pragma unroll
        for (int j = 0; j < 4; ++j) r[c][j] = cvt_pk_bf16(v[2 * j] * sc * gn[2 * j], v[2 * j + 1] * sc * gn[2 * j + 1]);
    }
}
__device__ __forceinline__ f32x16 qk_tile(const LAS unsigned char* Kl, const bf16x8 (&qf)[8], int r32, int hh) {
    f32x16 S;
#pragma unroll
    for (int i = 0; i < 16; ++i) S[i] = 0.f;
#pragma unroll
    for (int s = 0; s < 8; ++s) { const bf16x8 a = *(const LAS bf16x8*)(Kl + r32 * KP + (16 * s + 8 * hh) * 2); S = __builtin_amdgcn_mfma_f32_32x32x16_bf16(a, qf[s], S, 0, 0, 0); }
    return S;
}
__device__ __forceinline__ void pv_tile(f32x16 (&O)[4], const LAS unsigned char* Vl, const f32x16& Pm, int lane) {
    bf16x8 pf[2];
#pragma unroll
    for (int s = 0; s < 2; ++s) {
        u32x4 w;
#pragma unroll
        for (int j = 0; j < 4; ++j) w[j] = cvt_pk_bf16(Pm[8 * s + 2 * j], Pm[8 * s + 2 * j + 1]);
        pf[s] = __builtin_bit_cast(bf16x8, w); }
    const int gi = lane >> 4, hh = gi >> 1, eh = gi & 1, q = (lane >> 2) & 3, p = lane & 3;
    const LAS unsigned char* vb = Vl + (4 * hh + q) * VP + (16 * eh + 4 * p) * 2;
#pragma unroll
    for (int mt = 0; mt < 4; ++mt)
#pragma unroll
        for (int s = 0; s < 2; ++s) {
            const s16x4 lo = __builtin_amdgcn_ds_read_tr16_b64_v4i16((LAS s16x4*)(vb + s * 16 * VP + mt * 64));
            const s16x4 hi = __builtin_amdgcn_ds_read_tr16_b64_v4i16((LAS s16x4*)(vb + s * 16 * VP + 8 * VP + mt * 64));
            const bf16x8 a = {lo[0], lo[1], lo[2], lo[3], hi[0], hi[1], hi[2], hi[3]};
            O[mt] = __builtin_amdgcn_mfma_f32_32x32x16_bf16(a, pf[s], O[mt], 0, 0, 0); }
}
__device__ __forceinline__ void store_ot(bf16_t* out_row, const f32x16 (&O)[4], float scale, int hh) {
#pragma unroll
    for (int mt = 0; mt < 4; ++mt)
#pragma unroll
        for (int q4 = 0; q4 < 4; ++q4) { u32x2 o; o[0] = cvt_pk_bf16(O[mt][4 * q4] * scale, O[mt][4 * q4 + 1] * scale); o[1] = cvt_pk_bf16(O[mt][4 * q4 + 2] * scale, O[mt][4 * q4 + 3] * scale);
            *(u32x2*)(out_row + 32 * mt + 8 * q4 + 4 * hh) = o; }
}

__device__ __forceinline__ void attn_dilated_phase(const Ctx& C, const Params& P) {
    const bf16_t* qkv = (const bf16_t*)(P.ws + WS_QKV); bf16_t* og = (bf16_t*)(P.ws + WS_OG); float* lse = (float*)(P.ws + WS_LSE);
    const float* biasd = (const float*)(P.ws + WS_BIASD);
    LAS unsigned char* wl = C.lds + C.wave * AW_BYTES; LAS unsigned char* Kl = wl + AW_K; LAS unsigned char* Vl = wl + AW_V; LAS float* Bl = (LAS float*)(wl + AW_BIAS);
    const int lane = C.lane, r32 = lane & 31, hh = lane >> 5;
    const int nw = C.G * 8;
    for (int item = C.bid * 8 + C.wave; item < 3 * 4096; item += nw) {
        const int g = item >> 12, b = (item >> 11) & 1, h = (item >> 7) & 15, rj = item & 127;
        const int lg = 2 * g, dil = 1 << lg;
        const int njt = 128 >> lg, r = rj / njt, j = rj - r * njt;
        const size_t tok0 = (size_t)b * SEQ + r;
        const bf16_t* qbase = qkv + (size_t)g * 6144 + h * 128;
        for (int i = lane; i < 132; i += 64) Bl[i] = (i < 129) ? biasd[(size_t)(g * 16 + h) * 132 + i] : 0.f;
        bf16x8 qf[8];
        {
            const bf16_t* qp = qbase + (tok0 + (size_t)(32 * j + r32) * dil) * NA + 8 * hh;
            u32x4 raw[8]; float ss = 0.f;
#pragma unroll
            for (int s = 0; s < 8; ++s) { raw[s] = *(const u32x4*)(qp + 16 * s);
#pragma unroll
                for (int k = 0; k < 4; ++k) { const float a = bf_lo(raw[s][k]), c = bf_hi(raw[s][k]); ss += a * a + c * c; } }
            ss = half_swap_sum(ss);
            const float sc = rsqrtf(ss * (1.f / 128.f) + EPS) * 0.08838834764831845f;
            const float* gq = P.a_q_gain + g * 128 + 8 * hh;
#pragma unroll
            for (int s = 0; s < 8; ++s) { const f32x4 g0 = *(const f32x4*)(gq + 16 * s), g1 = *(const f32x4*)(gq + 16 * s + 4);
                u32x4 w;
                w[0] = cvt_pk_bf16(bf_lo(raw[s][0]) * sc * g0[0], bf_hi(raw[s][0]) * sc * g0[1]); w[1] = cvt_pk_bf16(bf_lo(raw[s][1]) * sc * g0[2], bf_hi(raw[s][1]) * sc * g0[3]);
                w[2] = cvt_pk_bf16(bf_lo(raw[s][2]) * sc * g1[0], bf_hi(raw[s][2]) * sc * g1[1]); w[3] = cvt_pk_bf16(bf_lo(raw[s][3]) * sc * g1[2], bf_hi(raw[s][3]) * sc * g1[3]);
                qf[s] = __builtin_bit_cast(bf16x8, w); }
        }
        float gk[8];
        { const float* gp = P.a_k_gain + g * 128 + 8 * (lane & 15); const f32x4 a = *(const f32x4*)gp, c = *(const f32x4*)(gp + 4);
          gk[0] = a[0]; gk[1] = a[1]; gk[2] = a[2]; gk[3] = a[3]; gk[4] = c[0]; gk[5] = c[1]; gk[6] = c[2]; gk[7] = c[3]; }
        f32x16 O[4];
#pragma unroll
        for (int mt = 0; mt < 4; ++mt)
#pragma unroll
            for (int i = 0; i < 16; ++i) O[mt][i] = 0.f;
        float m = -1e30f, l = 0.f;
        const int i0 = (j >= 4) ? 0 : 4 - j;
        for (int i = i0; i < 5; ++i) {
            const int lk0 = 32 * (j - 4 + i);
            const bf16_t* kp = qbase + 2048 + (tok0 + (size_t)lk0 * dil) * NA;
            u32x4 kr[8], vr[8];
            tile_load(kr, kp, (size_t)dil * NA, lane); tile_load(vr, kp + 2048, (size_t)dil * NA, lane);
            tile_rownorm(kr, gk);
            tile_write(Kl, KP, kr, lane); tile_write(Vl, VP, vr, lane);
            f32x16 S = qk_tile(Kl, qf, r32, hh);
            const int dbase = 128 - 32 * i + r32;
            float mx = -1e30f;
#pragma unroll
            for (int c = 0; c < 16; ++c) { const int kk = (c & 3) + 8 * (c >> 2) + 4 * hh, delta = dbase - kk;
                const bool ok = (delta >= 0) && (delta <= 128);
                const float bv = Bl[ok ? delta : 0];
                const float v = ok ? S[c] + bv : -1e30f; S[c] = v; mx = fmaxf(mx, v); }
            mx = half_swap_max(mx);
            const float mn = fmaxf(m, mx), alpha = __expf(m - mn);
            float rs = 0.f;
#pragma unroll
            for (int c = 0; c < 16; ++c) { const float p = __expf(S[c] - mn); S[c] = p; rs += p; }
            rs = half_swap_sum(rs);
            l = l * alpha + rs; m = mn;
#pragma unroll
            for (int mt = 0; mt < 4; ++mt)
#pragma unroll
                for (int c = 0; c < 16; ++c) O[mt][c] *= alpha;
            pv_tile(O, Vl, S, lane);
        }
        const size_t tq = tok0 + (size_t)(32 * j + r32) * dil;
        store_ot(og + ((size_t)g * T + tq) * D + h * 128, O, 1.f / l, hh);
        if (hh == 0) lse[((size_t)g * T + tq) * 16 + h] = m + __logf(l);
    }
}

__device__ __forceinline__ void combine_phase(const Ctx& C, const Params& P) {
    const bf16_t* og = (const bf16_t*)(P.ws + WS_OG); const float* lse = (const float*)(P.ws + WS_LSE); bf16_t* y = (bf16_t*)(P.ws + WS_Y);
    const size_t n8 = (size_t)T * D / 8, stride = (size_t)C.G * 512;
    for (size_t i = (size_t)C.bid * 512 + C.tid; i < n8; i += stride) {
        const size_t t = i >> 8; const int h = (int)(i & 255) >> 4;
        const float l0 = lse[(0 * (size_t)T + t) * 16 + h], l1 = lse[(1 * (size_t)T + t) * 16 + h], l2 = lse[(2 * (size_t)T + t) * 16 + h];
        const float mx = fmaxf(l0, fmaxf(l1, l2)); const float e0 = __expf(l0 - mx), e1 = __expf(l1 - mx), e2 = __expf(l2 - mx), inv = 1.f / (e0 + e1 + e2);
        const float a0 = e0 * inv, a1 = e1 * inv, a2 = e2 * inv;
        const u32x4 v0 = *(const u32x4*)(og + i * 8), v1 = *(const u32x4*)(og + (size_t)T * D + i * 8), v2 = *(const u32x4*)(og + 2 * (size_t)T * D + i * 8);
        u32x4 o;
#pragma unroll
        for (int k = 0; k < 4; ++k) o[k] = cvt_pk_bf16(a0 * bf_lo(v0[k]) + a1 * bf_lo(v1[k]) + a2 * bf_lo(v2[k]), a0 * bf_hi(v0[k]) + a1 * bf_hi(v1[k]) + a2 * bf_hi(v2[k]));
        *(u32x4*)(y + i * 8) = o; }
}

constexpr float SB_STOP = 110.f;
__device__ __forceinline__ void attn_stick_phase(const Ctx& C, const Params& P) {
    const bf16_t* qkv = (const bf16_t*)(P.ws + WS_QKV); bf16_t* y = (bf16_t*)(P.ws + WS_Y);
    LAS unsigned char* wl = C.lds + C.wave * AW_BYTES; LAS unsigned char* Kl = wl + AW_K; LAS unsigned char* Vl = wl + AW_V;
    const int lane = C.lane, r32 = lane & 31, hh = lane >> 5;
    const int nw = C.G * 8;
    for (int item = C.bid * 8 + C.wave; item < 4096; item += nw) {
        const int b = item >> 11, h = (item >> 7) & 15, qt = item & 127;
        const bf16_t* base = qkv + (size_t)b * SEQ * NBP + h * 128;
        bf16x8 qf[8];
        { const bf16_t* qp = base + (size_t)(32 * qt + r32) * NBP + 8 * hh;
#pragma unroll
          for (int s = 0; s < 8; ++s) { const u32x4 raw = *(const u32x4*)(qp + 16 * s); u32x4 w;
#pragma unroll
              for (int k = 0; k < 4; ++k) w[k] = cvt_pk_bf16(bf_lo(raw[k]) * 0.08838834764831845f, bf_hi(raw[k]) * 0.08838834764831845f);
              qf[s] = __builtin_bit_cast(bf16x8, w); } }
        f32x16 O[4];
#pragma unroll
        for (int mt = 0; mt < 4; ++mt)
#pragma unroll
            for (int i = 0; i < 16; ++i) O[mt][i] = 0.f;
        float carry = 0.f;
        for (int kt = qt; kt >= 0; --kt) {
            const bf16_t* kp = base + 2048 + (size_t)(32 * kt) * NBP;
            u32x4 kr[8], vr[8];
            tile_load(kr, kp, NBP, lane); tile_load(vr, kp + 2048, NBP, lane);
            tile_write(Kl, KP, kr, lane); tile_write(Vl, VP, vr, lane);
            f32x16 S = qk_tile(Kl, qf, r32, hh);
            const int lim = (kt == qt) ? r32 : 32;
            float sp[16], cs[4];
#pragma unroll
            for (int q4 = 0; q4 < 4; ++q4) { cs[q4] = 0.f;
#pragma unroll
                for (int e = 0; e < 4; ++e) { const int c = 4 * q4 + e, kk = e + 8 * q4 + 4 * hh; const float z = S[c];
                    const float s = (kk < lim) ? fmaxf(z, 0.f) + __logf(1.f + __expf(-fabsf(z))) : 0.f; sp[c] = s; cs[q4] += s; } }
            float pcs[4];
#pragma unroll
            for (int q4 = 0; q4 < 4; ++q4) { auto t2 = __builtin_amdgcn_permlane32_swap(__float_as_uint(cs[q4]), __float_as_uint(cs[q4]), false, false);
                pcs[q4] = hh ? __uint_as_float(t2[0]) : __uint_as_float(t2[1]); }
            float after = carry;
#pragma unroll
            for (int q4 = 3; q4 >= 0; --q4) {
                const float aft_chunk = after + (hh ? 0.f : pcs[q4]);
                float run = aft_chunk;
#pragma unroll
                for (int e = 3; e >= 0; --e) { const int c = 4 * q4 + e, kk = e + 8 * q4 + 4 * hh; const float z = S[c];
                    const float a = (kk < lim) ? __expf(z - sp[c] - run) : 0.f; run += sp[c]; S[c] = a; }
                after += cs[q4] + pcs[q4];
            }
            carry = after;
            pv_tile(O, Vl, S, lane);
            if (__all(carry >= SB_STOP)) break;
        }
        store_ot(y + ((size_t)b * SEQ + 32 * qt + r32) * D + h * 128, O, 1.f, hh);
    }
}
__device__ __forceinline__ int okey(float v, unsigned tag, unsigned tagmask) {
    const unsigned b = (__float_as_uint(v) & ~tagmask) | tag; return (int)(b ^ ((unsigned)((int)b >> 31) & 0x7fffffffu)); }
__device__ __forceinline__ unsigned okey_bits(int k) { const unsigned b = (unsigned)k; return b ^ ((unsigned)(k >> 31) & 0x7fffffffu); }
#define CE_DESC(a, b) do { const int _mx = max(a, b), _mn = min(a, b); a = _mx; b = _mn; } while (0)
template <int N, int B> __device__ __forceinline__ void sort16_desc(int (&k)[N]) {
#pragma unroll
    for (int size = 2; size <= 16; size <<= 1)
#pragma unroll
        for (int stride = size >> 1; stride > 0; stride >>= 1)
#pragma unroll
            for (int i = 0; i < 16; ++i) { const int j = i ^ stride;
                if (j > i) { if ((i & size) == 0) { CE_DESC(k[B + i], k[B + j]); } else { CE_DESC(k[B + j], k[B + i]); } } }
}
template <int N, int A, int Bq> __device__ __forceinline__ void merge16_desc(int (&k)[N]) {
#pragma unroll
    for (int i = 0; i < 16; ++i) k[A + i] = max(k[A + i], k[Bq + 15 - i]);
#pragma unroll
    for (int stride = 8; stride > 0; stride >>= 1)
#pragma unroll
        for (int i = 0; i < 16; ++i) { const int j = i ^ stride; if (j > i) { CE_DESC(k[A + i], k[A + j]); } }
}
template <int NA_, int A, int NB_, int Bq> __device__ __forceinline__ void merge16_desc2(int (&ka)[NA_], const int (&kb)[NB_]) {
#pragma unroll
    for (int i = 0; i < 16; ++i) ka[A + i] = max(ka[A + i], kb[Bq + 15 - i]);
#pragma unroll
    for (int stride = 8; stride > 0; stride >>= 1)
#pragma unroll
        for (int i = 0; i < 16; ++i) { const int j = i ^ stride; if (j > i) { CE_DESC(ka[A + i], ka[A + j]); } }
}
struct PairTab { int i[64], j[64], n; };
constexpr PairTab make_pairs() { PairTab t{}; int n = 0; for (int i = 0; i < 16; ++i) for (int j = 0; j < 16; ++j) if ((i + 1) * (j + 1) <= 16) { t.i[n] = i; t.j[n] = j; ++n; } t.n = n; return t; }

__device__ __forceinline__ void peer_topk_phase(const Ctx& C, const Params& P, int layer) {
    const bf16_t* pq = (const bf16_t*)(P.ws + WS_PQ); const bf16_t* keys = (const bf16_t*)(P.ws + WS_KEYS) + (size_t)layer * 8 * 2 * 128 * 128;
    int* seli = (int*)(P.ws + WS_SELI); float* selg = (float*)(P.ws + WS_SELG);
    const int lane = C.lane, r32 = lane & 31, hh = lane >> 5;
    const int nw = C.G * 8;
    for (int item = C.bid * 8 + C.wave; item < 256 * 8; item += nw) {
        const int tt = item >> 3, h = item & 7;
        int k[16];
        {
            const bf16_t* qp = pq + (size_t)(32 * tt + r32) * D + h * 256 + 8 * hh;
            const bf16_t* kp = keys + ((size_t)(h * 2) * 128 + r32) * 128 + 8 * hh;
#pragma unroll
            for (int nt = 0; nt < 4; ++nt) {
                f32x16 X0, X1;
#pragma unroll
                for (int i = 0; i < 16; ++i) { X0[i] = 0.f; X1[i] = 0.f; }
#pragma unroll
                for (int s = 0; s < 8; ++s) { const bf16x8 a = *(const bf16x8*)(kp + (size_t)nt * 32 * 128 + 16 * s); const bf16x8 q = *(const bf16x8*)(qp + 16 * s);
                    X0 = __builtin_amdgcn_mfma_f32_32x32x16_bf16(a, q, X0, 0, 0, 0); }
#pragma unroll
                for (int s = 0; s < 8; ++s) { const bf16x8 a = *(const bf16x8*)(kp + (size_t)(128 + nt * 32) * 128 + 16 * s); const bf16x8 q = *(const bf16x8*)(qp + 128 + 16 * s);
                    X1 = __builtin_amdgcn_mfma_f32_32x32x16_bf16(a, q, X1, 0, 0, 0); }
                int k32[32];
#pragma unroll
                for (int c = 0; c < 16; ++c) {
                    auto t2 = __builtin_amdgcn_permlane32_swap(__float_as_uint(X0[c]), __float_as_uint(X1[c]), false, false);
                    const int key0 = 32 * nt + (c & 3) + 8 * (c >> 2);
                    k32[2 * c] = okey(__uint_as_float(t2[0]), (unsigned)key0, 127u);
                    k32[2 * c + 1] = okey(__uint_as_float(t2[1]), (unsigned)(key0 + 4), 127u); }
                sort16_desc<32, 0>(k32); sort16_desc<32, 16>(k32); merge16_desc<32, 0, 16>(k32);
                if (nt == 0) {
#pragma unroll
                    for (int i = 0; i < 16; ++i) k[i] = k32[i];
                } else merge16_desc2<16, 0, 32, 0>(k, k32);
                __builtin_amdgcn_sched_barrier(0);
            }
        }
        float av[16], bv[16]; unsigned apk[4] = {0u, 0u, 0u, 0u}, bpk[4] = {0u, 0u, 0u, 0u};
#pragma unroll
        for (int i = 0; i < 16; ++i) {
            const unsigned bits = okey_bits(k[i]);
            auto t2 = __builtin_amdgcn_permlane32_swap(bits, bits, false, false);
            const unsigned ab = t2[0], bb = t2[1];
            av[i] = __uint_as_float(ab & ~127u); bv[i] = __uint_as_float(bb & ~127u);
            apk[i >> 2] |= (ab & 127u) << (8 * (i & 3)); bpk[i >> 2] |= (bb & 127u) << (8 * (i & 3)); }
        constexpr PairTab PT = make_pairs();
        int k2[64];
#pragma unroll
        for (int s = 0; s < 64; ++s) k2[s] = (s < PT.n) ? okey(av[PT.i[s < PT.n ? s : 0]] + bv[PT.j[s < PT.n ? s : 0]], (unsigned)(PT.i[s < PT.n ? s : 0] * 16 + PT.j[s < PT.n ? s : 0]), 255u) : (int)0x80000000;
        sort16_desc<64, 0>(k2); sort16_desc<64, 16>(k2); sort16_desc<64, 32>(k2); sort16_desc<64, 48>(k2);
        merge16_desc<64, 0, 16>(k2); merge16_desc<64, 32, 48>(k2); merge16_desc<64, 0, 32>(k2);
        float bs[16]; int eid[16];
#pragma unroll
        for (int w = 0; w < 16; ++w) { const unsigned bits = okey_bits(k2[w]); const unsigned code = bits & 255u, ci = code >> 4, cj = code & 15u;
            bs[w] = __uint_as_float(bits & ~255u);
            const unsigned aw = (ci >> 2) == 0 ? apk[0] : (ci >> 2) == 1 ? apk[1] : (ci >> 2) == 2 ? apk[2] : apk[3];
            const unsigned bw = (cj >> 2) == 0 ? bpk[0] : (cj >> 2) == 1 ? bpk[1] : (cj >> 2) == 2 ? bpk[2] : bpk[3];
            eid[w] = (int)(((aw >> (8 * (ci & 3))) & 127u) * 128u + ((bw >> (8 * (cj & 3))) & 127u)); }
        float sum = 0.f; const float bmax = bs[0];
#pragma unroll
        for (int w = 0; w < 16; ++w) { bs[w] = __expf(bs[w] - bmax); sum += bs[w]; }
        const float inv = 1.f / sum;
        if (hh == 0) {
            int* ip = seli + (size_t)(32 * tt + r32) * 128 + h * 16; float* gp = selg + (size_t)(32 * tt + r32) * 128 + h * 16;
#pragma unroll
            for (int w = 0; w < 16; w += 4) { *(int4*)(ip + w) = make_int4(eid[w], eid[w + 1], eid[w + 2], eid[w + 3]);
                *(f32x4*)(gp + w) = (f32x4){bs[w] * inv, bs[w + 1] * inv, bs[w + 2] * inv, bs[w + 3] * inv}; }
        }
    }
}

__device__ __forceinline__ float rl_f(float x, int l) { return __int_as_float(__builtin_amdgcn_readlane(__float_as_int(x), l)); }
__device__ __forceinline__ float gelu_exact(float v) { return 0.5f * v * (1.f + erff(v * 0.70710678118654752f)); }
__device__ __forceinline__ void peer_gather_phase(const Ctx& C, const Params& P, int layer, const float* hin, float* hout, const float* gate2) {
    const bf16_t* xf = (const bf16_t*)(P.ws + WS_XM);
    const unsigned char* U = P.ws + WS_U + (size_t)layer * NE * D; const unsigned char* V = P.ws + WS_V + (size_t)layer * NE * D;
    const int* seli = (const int*)(P.ws + WS_SELI); const float* selg = (const float*)(P.ws + WS_SELG);
    const int lane = C.lane, nw = C.G * 8;
    for (int t = C.bid * 8 + C.wave; t < T; t += nw) {
        f32x2 xv[16];
#pragma unroll
        for (int c = 0; c < 2; ++c)
#pragma unroll
            for (int q = 0; q < 2; ++q) { const u32x4 r = *(const u32x4*)(xf + (size_t)t * D + 1024 * c + 16 * lane + 8 * q);
#pragma unroll
                for (int j = 0; j < 4; ++j) xv[8 * c + 4 * q + j] = (f32x2){bf_lo(r[j]), bf_hi(r[j])}; }
        const int e_lo = seli[(size_t)t * 128 + lane], e_hi = seli[(size_t)t * 128 + 64 + lane];
        const float g_lo = selg[(size_t)t * 128 + lane], g_hi = selg[(size_t)t * 128 + 64 + lane];
        float w_lo = 0.f, w_hi = 0.f;
#pragma unroll 1
        for (int k0 = 0; k0 < 128; k0 += 16) {
            u32x4 ur[16][2];
#pragma unroll
            for (int q = 0; q < 16; ++q) { const int k = k0 + q; const int e = (k < 64) ? __builtin_amdgcn_readlane(e_lo, k & 63) : __builtin_amdgcn_readlane(e_hi, k & 63);
                const unsigned char* up = U + (size_t)e * D + 16 * lane;
                ur[q][0] = *(const u32x4*)up; ur[q][1] = *(const u32x4*)(up + 1024); }
#pragma unroll
            for (int q = 0; q < 16; ++q) { f32x2 d2 = {0.f, 0.f};
#pragma unroll
                for (int c = 0; c < 2; ++c)
#pragma unroll
                    for (int j = 0; j < 4; ++j) { d2 += __builtin_amdgcn_cvt_pk_f32_fp8((int)ur[q][c][j], false) * xv[8 * c + 2 * j]; d2 += __builtin_amdgcn_cvt_pk_f32_fp8((int)ur[q][c][j], true) * xv[8 * c + 2 * j + 1]; }
                const float d = wave_sum(d2.x + d2.y) * (1.f / U_SCALE);
                const int k = k0 + q; const float gk = (k < 64) ? rl_f(g_lo, k & 63) : rl_f(g_hi, k & 63);
                const float w = gelu_exact(d) * gk * (1.f / V_SCALE);
                if (k < 64) { w_lo = (lane == (k & 63)) ? w : w_lo; } else { w_hi = (lane == (k & 63)) ? w : w_hi; } }
        }
        f32x2 acc[16];
#pragma unroll
        for (int i = 0; i < 16; ++i) acc[i] = (f32x2){0.f, 0.f};
#pragma unroll 1
        for (int k0 = 0; k0 < 128; k0 += 16) {
            u32x4 vr[16][2];
#pragma unroll
            for (int q = 0; q < 16; ++q) { const int k = k0 + q; const int e = (k < 64) ? __builtin_amdgcn_readlane(e_lo, k & 63) : __builtin_amdgcn_readlane(e_hi, k & 63);
                const unsigned char* vp = V + (size_t)e * D + 16 * lane;
                vr[q][0] = *(const u32x4*)vp; vr[q][1] = *(const u32x4*)(vp + 1024); }
#pragma unroll
            for (int q = 0; q < 16; ++q) { const int k = k0 + q; const float w = (k < 64) ? rl_f(w_lo, k & 63) : rl_f(w_hi, k & 63);
#pragma unroll
                for (int c = 0; c < 2; ++c)
#pragma unroll
                    for (int j = 0; j < 4; ++j) { acc[8 * c + 2 * j] += __builtin_amdgcn_cvt_pk_f32_fp8((int)vr[q][c][j], false) * w; acc[8 * c + 2 * j + 1] += __builtin_amdgcn_cvt_pk_f32_fp8((int)vr[q][c][j], true) * w; } }
        }
        const int b = t >> 12;
#pragma unroll
        for (int c = 0; c < 2; ++c) { const size_t off = (size_t)t * D + 1024 * c + 16 * lane; const float* gp = gate2 + (size_t)b * MOD6 + 1024 * c + 16 * lane;
#pragma unroll
            for (int q = 0; q < 4; ++q) { const f32x4 hv = *(const f32x4*)(hin + off + 4 * q), gv = *(const f32x4*)(gp + 4 * q);
                f32x4 o; o[0] = hv[0] + gv[0] * acc[8 * c + 2 * q].x; o[1] = hv[1] + gv[1] * acc[8 * c + 2 * q].y; o[2] = hv[2] + gv[2] * acc[8 * c + 2 * q + 1].x; o[3] = hv[3] + gv[3] * acc[8 * c + 2 * q + 1].y;
                *(f32x4*)(hout + off + 4 * q) = o; } }
    }
}

typedef __bf16 bf16x2_t __attribute__((ext_vector_type(2)));
__device__ __forceinline__ unsigned pk_hi16(float lo, float hi) { return __builtin_amdgcn_perm(__float_as_uint(hi), __float_as_uint(lo), 0x07060302u); }
__device__ __forceinline__ float gelu_as(float v) {
    const float av = fabsf(v), t = __builtin_amdgcn_rcpf(av * 0.2316418882f + 1.0f);
    float q = t * 0.5307027145f + (-0.7265760135f); q = q * t + 0.7107068705f; q = q * t + (-0.142248368f); q = q * t + 0.127414796f; q = q * t;
    const float e = __builtin_amdgcn_exp2f((v * v) * (-0.72134752044f)), m = v * (q * e);
    return v < 0.f ? m : v - m; }
constexpr int GBATCH = 8;
constexpr int GB_SH = 10, GB_NB = NE >> GB_SH;
#define GB_PICK(q) do { const bool ok_ = (m_lo | m_hi) != 0ull; okv[q] = ok_; \
        if (ok_) { if (m_lo) { const int i_ = __builtin_ctzll(m_lo); m_lo &= m_lo - 1; code_ = i_; e_ = __builtin_amdgcn_readlane(e_lo[tk], i_); } \
                   else { const int i_ = __builtin_ctzll(m_hi); m_hi &= m_hi - 1; code_ = 64 + i_; e_ = __builtin_amdgcn_readlane(e_hi[tk], i_); } } \
        code[q] = code_; } while (0)
template <bool NEXT_NORM>
__device__ __forceinline__ void peer_gather_bucketed(const Ctx& C, const Params& P, int layer, const float* hin, float* hout, const float* gate2,
                                                     const float* ngain, const float* nshift, const float* nscale, bf16_t* xm_out) {
    const bf16_t* xf = (const bf16_t*)(P.ws + WS_XM);
    const unsigned char* U = P.ws + WS_U + (size_t)layer * NE * D; const unsigned char* V = P.ws + WS_V + (size_t)layer * NE * D;
    const int* seli = (const int*)(P.ws + WS_SELI); const float* selg = (const float*)(P.ws + WS_SELG);
    const int lane = C.lane, nw = C.G * 8;
    for (int tg = C.bid * 8 + C.wave; tg < T / 4; tg += nw) {
        const int t0 = 4 * tg;
        int e_lo[4], e_hi[4]; float g_lo[4], g_hi[4], w_lo[4], w_hi[4];
        u32x4 xr[4][4];
#pragma unroll
        for (int tk = 0; tk < 4; ++tk) { const size_t t = (size_t)(t0 + tk);
            e_lo[tk] = seli[t * 128 + lane]; e_hi[tk] = seli[t * 128 + 64 + lane]; g_lo[tk] = selg[t * 128 + lane]; g_hi[tk] = selg[t * 128 + 64 + lane]; w_lo[tk] = 0.f; w_hi[tk] = 0.f;
#pragma unroll
            for (int c = 0; c < 2; ++c)
#pragma unroll
                for (int q = 0; q < 2; ++q) xr[tk][2 * c + q] = *(const u32x4*)(xf + t * D + 1024 * c + 16 * lane + 8 * q); }
#pragma unroll 1
        for (int b = 0; b < GB_NB; ++b) {
#pragma unroll
            for (int tk = 0; tk < 4; ++tk) {
                unsigned long long m_lo = __ballot((e_lo[tk] >> GB_SH) == b), m_hi = __ballot((e_hi[tk] >> GB_SH) == b);
                while (m_lo | m_hi) {
                    int code[GBATCH]; bool okv[GBATCH]; u32x4 ur[GBATCH][2]; int code_ = 0, e_ = 0;
#pragma unroll
                    for (int q = 0; q < GBATCH; ++q) { GB_PICK(q);
                        const unsigned char* up = U + (size_t)e_ * D + 16 * lane;
                        ur[q][0] = *(const u32x4*)up; ur[q][1] = *(const u32x4*)(up + 1024); }
                    float dq[GBATCH];
#pragma unroll
                    for (int q = 0; q < GBATCH; ++q) {
                        float da = 0.f, db = 0.f;
#pragma unroll
                        for (int c = 0; c < 2; ++c)
#pragma unroll
                            for (int j = 0; j < 4; ++j) {
                                const unsigned x0 = xr[tk][2 * c + (j >> 1)][2 * (j & 1)], x1 = xr[tk][2 * c + (j >> 1)][2 * (j & 1) + 1];
                                const f32x2 u0 = __builtin_amdgcn_cvt_pk_f32_fp8((int)ur[q][c][j], false), u1 = __builtin_amdgcn_cvt_pk_f32_fp8((int)ur[q][c][j], true);
                                da = __builtin_amdgcn_fdot2_f32_bf16(__builtin_bit_cast(bf16x2_t, pk_hi16(u0.x, u0.y)), __builtin_bit_cast(bf16x2_t, x0), da, false);
                                db = __builtin_amdgcn_fdot2_f32_bf16(__builtin_bit_cast(bf16x2_t, pk_hi16(u1.x, u1.y)), __builtin_bit_cast(bf16x2_t, x1), db, false); }
                        dq[q] = da + db; }
                    const int myslot = ((lane >> 4) & 1) * 2 + (lane >> 5);
#pragma unroll
                    for (int q0 = 0; q0 < GBATCH; q0 += 4) if (okv[q0]) {
                        float dsum;
                        { auto s01 = __builtin_amdgcn_permlane32_swap(__float_as_uint(dq[q0]), __float_as_uint(dq[q0 + 1]), false, false);
                          auto s23 = __builtin_amdgcn_permlane32_swap(__float_as_uint(dq[q0 + 2]), __float_as_uint(dq[q0 + 3]), false, false);
                          const float r01 = __uint_as_float(s01[0]) + __uint_as_float(s01[1]), r23 = __uint_as_float(s23[0]) + __uint_as_float(s23[1]);
                          auto s4 = __builtin_amdgcn_permlane16_swap(__float_as_uint(r01), __float_as_uint(r23), false, false);
                          dsum = row16_sum(__uint_as_float(s4[0]) + __uint_as_float(s4[1])); }
                        float gsel;
                        { float gq[4];
#pragma unroll
                          for (int q = 0; q < 4; ++q) { const int i = code[q0 + q] & 63; gq[q] = (code[q0 + q] < 64) ? rl_f(g_lo[tk], i) : rl_f(g_hi[tk], i); }
                          gsel = myslot == 0 ? gq[0] : myslot == 1 ? gq[1] : myslot == 2 ? gq[2] : gq[3]; }
                        const float wv = gelu_as(dsum * (1.f / U_SCALE)) * gsel * (1.f / V_SCALE);
#pragma unroll
                        for (int q = 0; q < 4; ++q) if (okv[q0 + q]) {
                            const float w = rl_f(wv, q == 0 ? 0 : q == 1 ? 32 : q == 2 ? 16 : 48);
                            const int i = code[q0 + q] & 63;
                            if (code[q0 + q] < 64) { w_lo[tk] = (lane == i) ? w : w_lo[tk]; } else { w_hi[tk] = (lane == i) ? w : w_hi[tk]; } }
                    }
                }
            }
        }
        f32x2 acc[4][16];
#pragma unroll
        for (int tk = 0; tk < 4; ++tk)
#pragma unroll
            for (int i = 0; i < 16; ++i) acc[tk][i] = (f32x2){0.f, 0.f};
#pragma unroll 1
        for (int b = 0; b < GB_NB; ++b) {
#pragma unroll
            for (int tk = 0; tk < 4; ++tk) {
                unsigned long long m_lo = __ballot((e_lo[tk] >> GB_SH) == b), m_hi = __ballot((e_hi[tk] >> GB_SH) == b);
                while (m_lo | m_hi) {
                    int code[GBATCH]; bool okv[GBATCH]; u32x4 vr[GBATCH][2]; int code_ = 0, e_ = 0;
#pragma unroll
                    for (int q = 0; q < GBATCH; ++q) { GB_PICK(q);
                        const unsigned char* vp = V + (size_t)e_ * D + 16 * lane;
                        vr[q][0] = *(const u32x4*)vp; vr[q][1] = *(const u32x4*)(vp + 1024); }
#pragma unroll
                    for (int q = 0; q < GBATCH; ++q) if (okv[q]) {
                        const int i = code[q] & 63; const float w = (code[q] < 64) ? rl_f(w_lo[tk], i) : rl_f(w_hi[tk], i);
#pragma unroll
                        for (int c = 0; c < 2; ++c)
#pragma unroll
                            for (int j = 0; j < 4; ++j) { acc[tk][8 * c + 2 * j] += __builtin_amdgcn_cvt_pk_f32_fp8((int)vr[q][c][j], false) * w; acc[tk][8 * c + 2 * j + 1] += __builtin_amdgcn_cvt_pk_f32_fp8((int)vr[q][c][j], true) * w; } }
                }
            }
        }
        const int bb = t0 >> 12;
#pragma unroll
        for (int tk = 0; tk < 4; ++tk) { const size_t t = (size_t)(t0 + tk);
            f32x4 o[2][4]; float ss = 0.f;
#pragma unroll
            for (int c = 0; c < 2; ++c) { const size_t off = t * D + 1024 * c + 16 * lane; const float* gp = gate2 + (size_t)bb * MOD6 + 1024 * c + 16 * lane;
#pragma unroll
                for (int q = 0; q < 4; ++q) { const f32x4 hv = *(const f32x4*)(hin + off + 4 * q), gv = *(const f32x4*)(gp + 4 * q);
                    f32x4 r; r[0] = hv[0] + gv[0] * acc[tk][8 * c + 2 * q].x; r[1] = hv[1] + gv[1] * acc[tk][8 * c + 2 * q].y; r[2] = hv[2] + gv[2] * acc[tk][8 * c + 2 * q + 1].x; r[3] = hv[3] + gv[3] * acc[tk][8 * c + 2 * q + 1].y;
                    o[c][q] = r; ss += r[0] * r[0] + r[1] * r[1] + r[2] * r[2] + r[3] * r[3];
                    *(f32x4*)(hout + off + 4 * q) = r; } }
            if (NEXT_NORM) {
                ss = wave_sum(ss); const float rn = rsqrtf(ss * (1.f / D) + EPS);
#pragma unroll
                for (int c = 0; c < 2; ++c) { const int col = 1024 * c + 16 * lane;
#pragma unroll
                    for (int q = 0; q < 4; q += 2) {
                        u32x4 pk;
#pragma unroll
                        for (int h2 = 0; h2 < 2; ++h2) { const int cc = col + 4 * (q + h2);
                            const f32x4 g = *(const f32x4*)(ngain + cc), sh = *(const f32x4*)(nshift + (size_t)bb * MOD6 + cc), sc = *(const f32x4*)(nscale + (size_t)bb * MOD6 + cc);
                            const f32x4 y = (o[c][q + h2] * rn * g) * (sc + 1.f) + sh;
                            pk[2 * h2] = cvt_pk_bf16(y[0], y[1]); pk[2 * h2 + 1] = cvt_pk_bf16(y[2], y[3]); }
                        *(u32x4*)(xm_out + t * D + col + 4 * q) = pk; } }
            }
        }
    }
}
__global__ void __launch_bounds__(512, 2) hybrid_fwd(Params P) {
    extern __shared__ __attribute__((aligned(16))) unsigned char lds_raw[];
    Ctx C; C.lds = (LAS unsigned char*)lds_raw; C.tid = threadIdx.x; C.lane = C.tid & 63; C.wave = __builtin_amdgcn_readfirstlane(C.tid >> 6); C.G = gridDim.x; C.bid = blockIdx.x;
    volatile LAS unsigned* xbw = (volatile LAS unsigned*)(C.lds + LDS_BYTES - 16);
    if (C.tid == 0) { xbw[0] = 0u; xbw[1] = 0u; xbw[2] = 0u; xbw[3] = 0u; }
    __syncthreads();
    const int lo = P.ph_lo, hi = P.ph_hi;
    const bool multi = (hi - lo) > 1;
    XcdBarrier bar; bar.bar = (unsigned*)(P.ws + WS_BAR); bar.x = 0; bar.st = xbw;
    if (multi) bar = xcd_barrier_post((unsigned*)(P.ws + WS_BAR), xbw);
#ifndef PH_MASK
#define PH_MASK 0x3ffff
#endif
#define IN(k) (lo <= (k) && (k) < hi && ((PH_MASK >> (k)) & 1))
#ifndef PH_TWICE
#define PH_TWICE 0
#endif
#define REP(k) for (int _r = 0; _r < (((PH_TWICE >> (k)) & 1) ? 2 : 1); ++_r)
#define SEAM(k) do { if (IN(k) && IN((k) + 1)) xcd_barrier(bar); } while (0)
    unsigned char* ws = P.ws;
    float* mod = (float*)(ws + WS_MOD);
    bf16_t* XM = (bf16_t*)(ws + WS_XM); float* H1 = (float*)(ws + WS_H1); float* H2 = (float*)(ws + WS_H2);
    bf16_t* QKV = (bf16_t*)(ws + WS_QKV); bf16_t* Y = (bf16_t*)(ws + WS_Y); bf16_t* PQ = (bf16_t*)(ws + WS_PQ);
    const bf16_t* WinA = (const bf16_t*)(ws + WS_WINA); const bf16_t* WinB = (const bf16_t*)(ws + WS_WINB);
    const bf16_t* Wout = (const bf16_t*)(ws + WS_WOUT); const bf16_t* Wq = (const bf16_t*)(ws + WS_WQ);

    if (IN(0)) REP(0) p0_prologue(C, P);
    SEAM(0);
    if (IN(1)) REP(1) norm_mod_phase(C, P.x, P.norm1_g, mod + 0 * D, mod + 1 * D, XM);
    SEAM(1);
    if (IN(2)) REP(2) { pg8::Gemm g{XM, WinA, T, NA, D}; pg8::StaticOrder S; S.init(T, NA, C.G, C.bid); pg8::EpiStoreBf16 E{QKV, NA}; pg8::gemm_phase(C.lds, g, S, E); }
    SEAM(2);
    if (IN(3)) REP(3) attn_dilated_phase(C, P);
    SEAM(3);
    if (IN(4)) REP(4) combine_phase(C, P);
    SEAM(4);
    if (IN(5)) REP(5) { pg8::Gemm g{Y, Wout, T, D, D}; pg8::StaticOrder S; S.init(T, D, C.G, C.bid); pg8::EpiResGate E{P.x, H1, mod + 2 * D}; pg8::gemm_phase(C.lds, g, S, E); }
    SEAM(5);
    if (IN(6)) REP(6) norm_mod_phase(C, H1, P.norm2_g, mod + 3 * D, mod + 4 * D, XM);
    SEAM(6);
    if (IN(7)) REP(7) { pg8::Gemm g{XM, Wq, T, D, D}; pg8::StaticOrder S; S.init(T, D, C.G, C.bid); pg8::EpiStoreBf16 E{PQ, D}; pg8::gemm_phase(C.lds, g, S, E); }
    SEAM(7);
    if (IN(8)) REP(8) peer_topk_phase(C, P, 0);
    SEAM(8);
    if (IN(9)) REP(9) peer_gather_bucketed<false>(C, P, 0, H1, H2, mod + 5 * D, nullptr, nullptr, nullptr, nullptr);
    SEAM(9);
    float* mod1 = mod + 2 * MOD6;
    if (IN(10)) REP(10) norm_mod_phase(C, H2, P.norm1_g + D, mod1 + 0 * D, mod1 + 1 * D, XM);
    SEAM(10);
    if (IN(11)) REP(11) { pg8::Gemm g{XM, WinB, T, NBP, D}; pg8::StaticOrder S; S.init(T, NBP, C.G, C.bid); pg8::EpiStoreBf16 E{QKV, NBP}; pg8::gemm_phase(C.lds, g, S, E); }
    SEAM(11);
    if (IN(12)) REP(12) attn_stick_phase(C, P);
    SEAM(12);
    if (IN(13)) REP(13) { pg8::Gemm g{Y, Wout + (size_t)D * D, T, D, D}; pg8::StaticOrder S; S.init(T, D, C.G, C.bid); pg8::EpiResGate E{H2, H1, mod1 + 2 * D}; pg8::gemm_phase(C.lds, g, S, E); }
    SEAM(13);
    if (IN(14)) REP(14) norm_mod_phase(C, H1, P.norm2_g + D, mod1 + 3 * D, mod1 + 4 * D, XM);
    SEAM(14);
    if (IN(15)) REP(15) { pg8::Gemm g{XM, Wq + (size_t)D * D, T, D, D}; pg8::StaticOrder S; S.init(T, D, C.G, C.bid); pg8::EpiStoreBf16 E{PQ, D}; pg8::gemm_phase(C.lds, g, S, E); }
    SEAM(15);
    if (IN(16)) REP(16) peer_topk_phase(C, P, 1);
    SEAM(16);
    if (IN(17)) REP(17) peer_gather_bucketed<false>(C, P, 1, H1, P.out, mod1 + 5 * D, nullptr, nullptr, nullptr, nullptr);
#undef IN
#undef REP
#undef SEAM
}

#ifndef N_LAUNCH_MODE
#define N_LAUNCH_MODE 1
#endif
constexpr int N_PHASES = 18;
extern "C" void kernel_launch(void* const* d_in, const int* in_sizes, int n_in, void* d_out, int out_size, void* d_ws, size_t ws_size, hipStream_t stream) {
    static int grid = 0;
    if (grid == 0) {
        if (n_in != 16 || out_size != T * D || ws_size < WS_END) { fprintf(stderr, "kernel_launch: unexpected sizes (n_in %d out %d ws %zu need %zu)\n", n_in, out_size, ws_size, (size_t)WS_END); grid = -1; return; }
        int dev = 0, cus = 0, per_cu = 0;
        if (hipGetDevice(&dev) != hipSuccess || hipDeviceGetAttribute(&cus, hipDeviceAttributeMultiprocessorCount, dev) != hipSuccess) { grid = -1; return; }
        if (hipFuncSetAttribute((const void*)hybrid_fwd, hipFuncAttributeMaxDynamicSharedMemorySize, LDS_BYTES) != hipSuccess) { fprintf(stderr, "kernel_launch: hipFuncSetAttribute failed\n"); grid = -1; return; }
        if (hipOccupancyMaxActiveBlocksPerMultiprocessor(&per_cu, (const void*)hybrid_fwd, 512, LDS_BYTES) != hipSuccess || per_cu < 1) { fprintf(stderr, "kernel_launch: occupancy query says %d\n", per_cu); }
        (void)hipGetLastError();
        grid = cus;
    }
    if (grid < 0) return;
    (void)hipMemsetAsync((char*)d_ws + WS_BAR, 0, 16384, stream);
    Params p{};
    p.x = (const float*)d_in[0]; p.c = (const float*)d_in[1]; p.rel_bias = (const float*)d_in[2]; p.norm1_g = (const float*)d_in[3]; p.norm2_g = (const float*)d_in[4];
    p.w_ada = (const float*)d_in[5]; p.b_ada = (const float*)d_in[6]; p.a_w_in = (const float*)d_in[7]; p.a_q_gain = (const float*)d_in[8]; p.a_k_gain = (const float*)d_in[9];
    p.b_w_in = (const float*)d_in[10]; p.w_out = (const float*)d_in[11]; p.peer_wq = (const float*)d_in[12]; p.peer_keys = (const float*)d_in[13]; p.peer_u = (const float*)d_in[14]; p.peer_v = (const float*)d_in[15];
    p.out = (float*)d_out; p.ws = (unsigned char*)d_ws;
    if (N_LAUNCH_MODE == 1) { p.ph_lo = 0; p.ph_hi = N_PHASES; hipLaunchKernelGGL(hybrid_fwd, dim3(grid), dim3(512), LDS_BYTES, stream, p); }
    else for (int k = 0; k < N_PHASES; ++k) { p.ph_lo = k; p.ph_hi = k + 1; hipLaunchKernelGGL(hybrid_fwd, dim3(grid), dim3(512), LDS_BYTES, stream, p); }
}
```
